# Optimizing an MI355X kernel written in HIP

```python
import math
import jax, jax.numpy as jnp
from jax import lax
import numpy as np

D_MODEL = 1024
BATCH = 8
SEQ = 2048
DEPTH = 4
DEC_BATCH = 128
DEC_SEQ = 4
PAST_LEN = 16384
PAGE_SIZE = 128

N_EVEN = (DEPTH + 1) // 2
N_ODD = DEPTH // 2
W_A = D_MODEL // 2
A_BLOCKS = 8
A_BLOCK = W_A // A_BLOCKS
A_CONV = 4
LRU_C = 8.0
W_B = D_MODEL // 2
B_GROUPS = 8
B_CONV = 3
C_HEADS = 4
C_DK = 64
C_DV = 128
W_CK = C_HEADS * C_DK
W_CV = C_HEADS * C_DV
RET_CHUNK = 128
ROPE_BASE = 10000.0
D_GROUPS = 4
D_CHUNK = 128
W_D = D_MODEL // 2
D_GROUP = W_D // D_GROUPS
EVEN_IN = 2 * W_A + 3 * W_B
ODD_IN = 2 * W_CK + 2 * W_CV + 2 * W_D
MIX_OUT = W_A + W_B
D_FF = -(-8 * D_MODEL // (3 * 256)) * 256
ALPHA = (2 * DEPTH) ** 0.25
BETA = (8 * DEPTH) ** -0.25
LN_EPS = 1e-5

kernel_name = "hybrid_rglru_conv_retention_gmlp_decoder_step"


def layer_norm(x, g, b):
    xf = x.astype(jnp.float32)
    mu = jnp.mean(xf, -1, keepdims=True)
    var = jnp.mean(jnp.square(xf - mu), -1, keepdims=True)
    return ((xf - mu) * lax.rsqrt(var + LN_EPS) * g.astype(jnp.float32) + b.astype(jnp.float32)).astype(x.dtype)


def causal_dwconv(x, prefix, w):
    K = w.shape[0]
    T = x.shape[1]
    xp = jnp.concatenate([prefix.astype(x.dtype), x], axis=1)
    y = sum(w[j] * xp[:, j:j + T] for j in range(K))
    return y, xp[:, xp.shape[1] - (K - 1):]


def rg_lru(x, h0, wa, ba, wx, bx, lam):
    N, T, _ = x.shape
    xb = x.reshape(N, T, A_BLOCKS, A_BLOCK)
    r = jax.nn.sigmoid((jnp.einsum('ntgi,gij->ntgj', xb, wa).reshape(N, T, W_A) + ba).astype(jnp.float32))
    i = jax.nn.sigmoid((jnp.einsum('ntgi,gij->ntgj', xb, wx).reshape(N, T, W_A) + bx).astype(jnp.float32))
    log_a = -LRU_C * r * jax.nn.softplus(-lam.astype(jnp.float32))
    a = jnp.exp(log_a)
    mult = jnp.sqrt(-jnp.expm1(2.0 * log_a))
    if h0 is None:
        mult = mult.at[:, 0].set(1.0)
    b = mult * (i * x.astype(jnp.float32))
    if h0 is not None:
        b = b.at[:, 0].add(a[:, 0] * h0.astype(jnp.float32))

    def combine(left, right):
        a1, b1 = left
        a2, b2 = right
        return a1 * a2, a2 * b1 + b2

    _, h = lax.associative_scan(combine, (a, b), axis=1)
    return h.astype(x.dtype), h[:, -1]


def mixer_ab(x, conv_a_buf, h0, sconv_buf, w_in, conv_a_w, conv_a_b, lru_wa, lru_ba, lru_wx, lru_bx, lru_lam, conv_b_w, w_out):
    proj = x @ w_in
    xa, ga, bg, cg, xb = jnp.split(proj, [W_A, 2 * W_A, 2 * W_A + W_B, 2 * W_A + 2 * W_B], axis=-1)
    xa_c, new_conv_a = causal_dwconv(xa, conv_a_buf, conv_a_w)
    h, h_last = rg_lru(xa_c + conv_a_b, h0, lru_wa, lru_ba, lru_wx, lru_bx, lru_lam)
    ya = h * jax.nn.gelu(ga)
    zb, new_sconv = causal_dwconv(cg * xb, sconv_buf, conv_b_w)
    yb = bg * zb
    y = jnp.concatenate([ya, yb], axis=-1) @ w_out
    return y, new_conv_a, h_last, new_sconv


def rope(x, pos):
    half = x.shape[-1] // 2
    freq = ROPE_BASE ** (-jnp.arange(half, dtype=jnp.float32) / half)
    ang = pos.astype(jnp.float32)[:, None] * freq
    cos = jnp.cos(ang)[None, :, None, :]
    sin = jnp.sin(ang)[None, :, None, :]
    xf = x.astype(jnp.float32)
    x1, x2 = xf[..., :half], xf[..., half:]
    return jnp.concatenate([x1 * cos - x2 * sin, x1 * sin + x2 * cos], axis=-1)


def retention_chunk(q, k, v, S0):
    L = q.shape[1]
    log_g = jnp.log1p(-jnp.exp2(-5.0 - jnp.arange(C_HEADS, dtype=jnp.float32)))
    idx = jnp.arange(L, dtype=jnp.float32)
    rel = idx[:, None] - idx[None, :]
    decay = jnp.where(rel >= 0, jnp.exp(log_g[:, None, None] * jnp.maximum(rel, 0.0)), 0.0)
    scores = jnp.einsum('nlhd,nmhd->nhlm', q, k) * decay
    intra = jnp.einsum('nhlm,nmhe->nlhe', scores, v)
    cross = jnp.einsum('nlhd,nhde->nlhe', q, S0) * jnp.exp(log_g[None, :] * (idx[:, None] + 1.0))[None, :, :, None]
    k_dec = k * jnp.exp(log_g[None, :] * (L - 1.0 - idx[:, None]))[None, :, :, None]
    S_new = jnp.exp(log_g * L)[None, :, None, None] * S0 + jnp.einsum('nlhd,nlhe->nhde', k_dec, v)
    return intra + cross, S_new


def retention(q, k, v, S0):
    N, T = q.shape[:2]
    if T <= RET_CHUNK:
        return retention_chunk(q, k, v, S0)
    nc = T // RET_CHUNK

    def to_chunks(a):
        return jnp.moveaxis(a.reshape(N, nc, RET_CHUNK, *a.shape[2:]), 1, 0)

    def step(S, qkv):
        o, S_next = retention_chunk(qkv[0], qkv[1], qkv[2], S)
        return S_next, o

    S_fin, o = lax.scan(step, S0, (to_chunks(q), to_chunks(k), to_chunks(v)))
    return jnp.moveaxis(o, 0, 1).reshape(N, T, C_HEADS, C_DV), S_fin


def mixer_cd(x, S0, pos, w_in, ret_gn_g, sp_w, sp_b, gm_ln_g, gm_ln_b, w_out):
    N, T, _ = x.shape
    proj = x @ w_in
    q, k, v, g, u, vd = jnp.split(proj, [W_CK, 2 * W_CK, 2 * W_CK + W_CV, 2 * W_CK + 2 * W_CV, 2 * W_CK + 2 * W_CV + W_D], axis=-1)
    qh = rope(q.reshape(N, T, C_HEADS, C_DK), pos)
    kh = rope(k.reshape(N, T, C_HEADS, C_DK), pos) * (C_DK ** -0.5)
    vh = v.reshape(N, T, C_HEADS, C_DV).astype(jnp.float32)
    o, S_new = retention(qh, kh, vh, S0.astype(jnp.float32))
    mu = jnp.mean(o, -1, keepdims=True)
    var = jnp.mean(jnp.square(o - mu), -1, keepdims=True)
    o = ((o - mu) * lax.rsqrt(var + LN_EPS)).reshape(N, T, W_CV) * ret_gn_g.astype(jnp.float32)
    y_c = (jax.nn.silu(g.astype(jnp.float32)) * o).astype(x.dtype)
    u = jax.nn.gelu(u)
    vd = layer_norm(jax.nn.gelu(vd), gm_ln_g, gm_ln_b)
    Lc = min(T, D_CHUNK)
    nc = T // Lc
    w_s = jnp.tril(sp_w[:, :Lc, :Lc])
    vc = vd.reshape(N, nc, Lc, D_GROUPS, D_GROUP)
    s = jnp.einsum('gts,ncsgd->nctgd', w_s, vc) + jnp.swapaxes(sp_b[:, :Lc], 0, 1)[:, :, None]
    y_d = (u * s.reshape(N, T, W_D)).astype(x.dtype)
    y = jnp.concatenate([y_c, y_d], axis=-1) @ w_out
    return y, S_new, vd


def swiglu(x, w1, w3, w2):
    return (jax.nn.silu(x @ w1) * (x @ w3)) @ w2


def setup_inputs(seed: int = 0) -> dict:
    key = jax.random.key(seed)
    ks = iter(jax.random.split(key, 40))
    nrm = lambda shape, s: jax.random.normal(next(ks), shape, jnp.float32) * s
    u = jax.random.uniform(next(ks), (N_EVEN, W_A), jnp.float32, 0.9, 0.999)
    sg = u ** (1.0 / LRU_C)
    lru_lam = jnp.log(sg) - jnp.log1p(-sg)
    return {
        "x_prompt": nrm((BATCH, SEQ, D_MODEL), 1.0),
        "x_sample": nrm((DEC_BATCH, DEC_SEQ, D_MODEL), 1.0),
        "state_lru_h": nrm((DEC_BATCH, N_EVEN, W_A), 0.5),
        "state_lru_conv": nrm((DEC_BATCH, N_EVEN, A_CONV - 1, W_A), 1.0),
        "state_sconv": nrm((DEC_BATCH, N_EVEN, B_CONV - 1, W_B), 1.0),
        "state_ret": nrm((DEC_BATCH, N_ODD, C_HEADS, C_DK, C_DV), 1.0),
        "w_in_even": nrm((N_EVEN, D_MODEL, EVEN_IN), D_MODEL ** -0.5),
        "conv_a_w": nrm((N_EVEN, A_CONV, W_A), A_CONV ** -0.5),
        "conv_a_b": nrm((N_EVEN, W_A), 0.01),
        "lru_wa": nrm((N_EVEN, A_BLOCKS, A_BLOCK, A_BLOCK), A_BLOCK ** -0.5),
        "lru_ba": nrm((N_EVEN, W_A), 0.01),
        "lru_wx": nrm((N_EVEN, A_BLOCKS, A_BLOCK, A_BLOCK), A_BLOCK ** -0.5),
        "lru_bx": nrm((N_EVEN, W_A), 0.01),
        "lru_lam": lru_lam,
        "conv_b_w": nrm((N_EVEN, B_CONV, W_B), B_CONV ** -0.5),
        "w_out_even": nrm((N_EVEN, MIX_OUT, D_MODEL), BETA * MIX_OUT ** -0.5),
        "w_in_odd": nrm((N_ODD, D_MODEL, ODD_IN), D_MODEL ** -0.5),
        "ret_gn_g": 1.0 + nrm((N_ODD, W_CV), 0.01),
        "sp_w": nrm((N_ODD, D_GROUPS, D_CHUNK, D_CHUNK), D_CHUNK ** -0.5),
        "sp_b": nrm((N_ODD, D_GROUPS, D_CHUNK), 0.01),
        "gm_ln_g": 1.0 + nrm((N_ODD, W_D), 0.01),
        "gm_ln_b": nrm((N_ODD, W_D), 0.01),
        "w_out_odd": nrm((N_ODD, W_CV + W_D, D_MODEL), BETA * (W_CV + W_D) ** -0.5),
        "ffn_w1": nrm((DEPTH, D_MODEL, D_FF), D_MODEL ** -0.5),
        "ffn_w3": nrm((DEPTH, D_MODEL, D_FF), D_MODEL ** -0.5),
        "ffn_w2": nrm((DEPTH, D_FF, D_MODEL), BETA * D_FF ** -0.5),
        "ln1_g": 1.0 + nrm((DEPTH, D_MODEL), 0.01),
        "ln1_b": nrm((DEPTH, D_MODEL), 0.01),
        "ln2_g": 1.0 + nrm((DEPTH, D_MODEL), 0.01),
        "ln2_b": nrm((DEPTH, D_MODEL), 0.01),
    }


def reference(x_prompt, x_sample, state_lru_h, state_lru_conv, state_sconv, state_ret,
              w_in_even, conv_a_w, conv_a_b, lru_wa, lru_ba, lru_wx, lru_bx, lru_lam, conv_b_w, w_out_even,
              w_in_odd, ret_gn_g, sp_w, sp_b, gm_ln_g, gm_ln_b, w_out_odd,
              ffn_w1, ffn_w3, ffn_w2, ln1_g, ln1_b, ln2_g, ln2_b):
    xp, xs = x_prompt, x_sample
    pos_p = jnp.arange(SEQ, dtype=jnp.int32)
    pos_s = PAST_LEN + jnp.arange(DEC_SEQ, dtype=jnp.int32)
    h_p, h_s, ca_p, ca_s, sc_p, sc_s, r_p, r_s, v_s = [], [], [], [], [], [], [], [], []
    for l in range(DEPTH):
        if l % 2 == 0:
            e = l // 2
            pa = (w_in_even[e], conv_a_w[e], conv_a_b[e], lru_wa[e], lru_ba[e], lru_wx[e], lru_bx[e], lru_lam[e], conv_b_w[e], w_out_even[e])
            mp, cap, hlp, scp = mixer_ab(xp, jnp.zeros((BATCH, A_CONV - 1, W_A), xp.dtype), None,
                                         jnp.zeros((BATCH, B_CONV - 1, W_B), xp.dtype), *pa)
            ms, cas, hls, scs = mixer_ab(xs, state_lru_conv[:, e], state_lru_h[:, e], state_sconv[:, e], *pa)
            h_p.append(hlp.astype(xp.dtype)); h_s.append(hls.astype(state_lru_h.dtype))
            ca_p.append(cap); ca_s.append(cas.astype(state_lru_conv.dtype))
            sc_p.append(scp); sc_s.append(scs.astype(state_sconv.dtype))
        else:
            o = l // 2
            po = (w_in_odd[o], ret_gn_g[o], sp_w[o], sp_b[o], gm_ln_g[o], gm_ln_b[o], w_out_odd[o])
            mp, rp, _ = mixer_cd(xp, jnp.zeros((BATCH, C_HEADS, C_DK, C_DV), jnp.float32), pos_p, *po)
            ms, rs, vs = mixer_cd(xs, state_ret[:, o], pos_s, *po)
            r_p.append(rp.astype(xp.dtype)); r_s.append(rs.astype(state_ret.dtype))
            v_s.append(vs)
        xp = layer_norm(ALPHA * xp + mp, ln1_g[l], ln1_b[l])
        xs = layer_norm(ALPHA * xs + ms, ln1_g[l], ln1_b[l])
        xp = layer_norm(ALPHA * xp + swiglu(xp, ffn_w1[l], ffn_w3[l], ffn_w2[l]), ln2_g[l], ln2_b[l])
        xs = layer_norm(ALPHA * xs + swiglu(xs, ffn_w1[l], ffn_w3[l], ffn_w2[l]), ln2_g[l], ln2_b[l])
    lru_h_prompt = jnp.stack(h_p, axis=1)
    lru_h_sample = jnp.stack(h_s, axis=1)
    lru_conv_prompt = jnp.stack(ca_p, axis=1)
    lru_conv_sample = jnp.stack(ca_s, axis=1)
    sconv_prompt = jnp.stack(sc_p, axis=1)
    sconv_sample = jnp.stack(sc_s, axis=1)
    ret_prompt = jnp.stack(r_p, axis=1)
    ret_sample = jnp.stack(r_s, axis=1)
    chunk_v_sample = jnp.stack(v_s, axis=1)
    return (xp, xs, lru_h_prompt, lru_h_sample, lru_conv_prompt, lru_conv_sample,
            sconv_prompt, sconv_sample, ret_prompt, ret_sample, chunk_v_sample)
```

```cpp
#include <hip/hip_runtime.h>
#include <cstdio>
#include <cstdint>
#define HD __host__ __device__ __forceinline__
#ifndef T_BATCH
#define T_BATCH 8
#endif
#ifndef T_SEQ
#define T_SEQ 2048
#endif
#ifndef T_DEC
#define T_DEC 128
#endif
typedef unsigned short bf16;
constexpr int BATCH = T_BATCH, SEQ = T_SEQ, DECB = T_DEC, DECS = 4, DM = 1024, DEPTH = 4;
constexpr int NIN = 2560, DFF = 2816, NC = SEQ / 128, PAST = 16384;
constexpr int MP = BATCH * SEQ, MS = DECB * DECS, M = MP + MS;
constexpr float ALPHA = 1.681792830507429f, LN_EPS = 1e-5f;
constexpr long O_Y = 0, O_HP = (long)M * DM, O_HS = O_HP + (long)BATCH * 1024, O_CAP = O_HS + (long)DECB * 1024, O_CAS = O_CAP + (long)BATCH * 3072,
               O_SCP = O_CAS + (long)DECB * 3072, O_SCS = O_SCP + (long)BATCH * 2048, O_RP = O_SCS + (long)DECB * 2048, O_RS = O_RP + (long)BATCH * 65536,
               O_CV = O_RS + (long)DECB * 65536, O_END = O_CV + (long)DECB * 4096;
constexpr size_t al256(size_t x) { return (x + 255) & ~(size_t)255; }
constexpr size_t WS_CTL = 0, WS_WIN = 1u << 20, WS_WOUT = WS_WIN + (size_t)4 * NIN * DM * 2, WS_W13 = WS_WOUT + (size_t)4 * DM * DM * 2,
                 WS_W2 = WS_W13 + (size_t)4 * 2 * DFF * DM * 2, WS_XB = WS_W2 + (size_t)4 * DM * DFF * 2, WS_PROJ = al256(WS_XB + (size_t)M * DM * 2),
                 WS_Y = al256(WS_PROJ + (size_t)M * NIN * 2), WS_ROPE = al256(WS_Y + (size_t)M * DM * 2), WS_SCR = al256(WS_ROPE + (size_t)(SEQ + 4) * 64 * 4);
constexpr size_t WS_H = WS_PROJ;
static_assert((size_t)M * DFF * 2 <= WS_ROPE - WS_PROJ, "H overlay");
constexpr int GR = (SEQ > MS ? SEQ : MS);
constexpr size_t SCR_A = 0, SCR_B = SCR_A + (size_t)GR * 512 * 4, SCR_C = SCR_B + (size_t)GR * 512 * 4, SCR_D = SCR_C + (size_t)GR * 512 * 4,
                 SCR_E = SCR_D + (size_t)NC * 4 * 8192 * 4, SCR_F = SCR_E + (size_t)NC * 4 * 8192 * 4, SCR_END = SCR_F + (size_t)NC * 4 * 16384 * 4;
constexpr size_t WS_END = WS_SCR + SCR_END;

struct P {
    const float *x_prompt, *x_sample, *state_lru_h, *state_lru_conv, *state_sconv, *state_ret;
    const float *w_in_even, *conv_a_w, *conv_a_b, *lru_wa, *lru_ba, *lru_wx, *lru_bx, *lru_lam, *conv_b_w, *w_out_even;
    const float *w_in_odd, *ret_gn_g, *sp_w, *sp_b, *gm_ln_g, *gm_ln_b, *w_out_odd;
    const float *ffn_w1, *ffn_w3, *ffn_w2, *ln1_g, *ln1_b, *ln2_g, *ln2_b;
    float* out; unsigned char* ws;
    bf16 *Wt_in, *Wt_out, *Wt_13, *Wt_2, *XB, *PROJ, *Y, *H;
    float *XF, *rope, *sA, *sB, *sC, *sD, *sE, *sF;
};
static inline void setup_P(P& p, void* const* d_in, void* d_out, void* d_ws) {
    const float** f = (const float**)&p.x_prompt;
    for (int i = 0; i < 30; ++i) f[i] = (const float*)d_in[i];
    p.out = (float*)d_out; p.ws = (unsigned char*)d_ws;
    p.Wt_in = (bf16*)(p.ws + WS_WIN); p.Wt_out = (bf16*)(p.ws + WS_WOUT); p.Wt_13 = (bf16*)(p.ws + WS_W13); p.Wt_2 = (bf16*)(p.ws + WS_W2);
    p.XB = (bf16*)(p.ws + WS_XB); p.PROJ = (bf16*)(p.ws + WS_PROJ); p.Y = (bf16*)(p.ws + WS_Y); p.H = (bf16*)(p.ws + WS_H);
    p.XF = p.out; p.rope = (float*)(p.ws + WS_ROPE);
    unsigned char* s = p.ws + WS_SCR;
    p.sA = (float*)(s + SCR_A); p.sB = (float*)(s + SCR_B); p.sC = (float*)(s + SCR_C); p.sD = (float*)(s + SCR_D); p.sE = (float*)(s + SCR_E); p.sF = (float*)(s + SCR_F);
}

HD bf16 f2bf(float f) { unsigned u = __builtin_bit_cast(unsigned, f); return (bf16)((u + 0x7fffu + ((u >> 16) & 1u)) >> 16); }
HD float bf2f(bf16 h) { return __builtin_bit_cast(float, (unsigned)h << 16); }
HD float sigmoidf_(float x) { return 1.0f / (1.0f + expf(-x)); }
HD float siluf_(float x) { return x * sigmoidf_(x); }
HD float geluf_(float x) { return 0.5f * x * (1.0f + tanhf(0.7978845608028654f * (x + 0.044715f * x * x * x))); }
HD float lgam(int h) { return h == 0 ? -0.0317486983145803f : h == 1 ? -0.015748356968139168f : h == 2 ? -0.007843177461025893f : -0.003913899321136329f; }
HD float gpow(int h, int n) { return expf((float)n * lgam(h)); }
struct RowInfo { int sample, s, t, T, base; };
HD RowInfo rowinfo(int row) { RowInfo r; if (row < MP) { r.sample = 0; r.s = row / SEQ; r.t = row % SEQ; r.T = SEQ; r.base = r.s * SEQ; } else { int q = row - MP; r.sample = 1; r.s = q / DECS; r.t = q % DECS; r.T = DECS; r.base = MP + r.s * DECS; } return r; }

struct FPrepW { const float* W; bf16* Wt; int K, N;
    HD void operator()(long g) const { int n = (int)(g / K), k = (int)(g % K); Wt[g] = f2bf(W[(long)k * N + n]); } };
struct FPrepW13 { const float *W1, *W3; bf16* Wt;
    HD void operator()(long g) const { int r = (int)(g / DM), k = (int)(g % DM); int tile = r >> 8, w = r & 255; const float* W = w < 128 ? W1 : W3; Wt[g] = f2bf(W[(long)k * DFF + tile * 128 + (w & 127)]); } };
struct FPrepX { P p;
    HD void operator()(long g) const { float v = g < (long)MP * DM ? p.x_prompt[g] : p.x_sample[g - (long)MP * DM]; p.XF[g] = v; p.XB[g] = f2bf(v); } };
struct FRope { float* cs;
    HD void operator()(long g) const { int pi = (int)(g / 32), i = (int)(g % 32); double pos = pi < SEQ ? (double)pi : (double)(PAST + pi - SEQ);
        double fr = 1.0; for (int j = 0; j < i; ++j) fr *= 0.7498942093324559;
        double ang = pos * fr, k = rint(ang * 0.15915494309189535), r = ang - k * 6.283185307179586; r -= k * 2.4492935982947064e-16;
        double r2 = r * r, sn = 0.0, cn = 0.0;
        for (int n = 14; n >= 1; --n) { sn = (sn + 1.0) * (-r2 / ((2.0 * n) * (2.0 * n + 1.0))); cn = (cn + 1.0) * (-r2 / ((2.0 * n - 1.0) * (2.0 * n))); }
        cs[2 * g] = (float)(cn + 1.0); cs[2 * g + 1] = (float)(r * (sn + 1.0)); } };

struct FLN { P p; const float* g; const float* b;
    HD void operator()(long row) const { float* z = p.XF + row * DM; float mu = 0.f; for (int c = 0; c < DM; ++c) mu += z[c]; mu *= (1.0f / DM);
        float var = 0.f; for (int c = 0; c < DM; ++c) { float d = z[c] - mu; var += d * d; } var *= (1.0f / DM); float rs = 1.0f / sqrtf(var + LN_EPS);
        for (int c = 0; c < DM; ++c) { float v = (z[c] - mu) * rs * g[c] + b[c]; z[c] = v; p.XB[row * DM + c] = f2bf(v); } } };

struct FE1 { P p; int e, r0;
    HD void operator()(long g) const { int row = r0 + (int)(g / 512), ch = (int)(g % 512); RowInfo ri = rowinfo(row);
        float acc = p.conv_a_b[e * 512 + ch];
        for (int j = 0; j < 4; ++j) { int tt = ri.t - 3 + j; float xv;
            if (tt >= 0) xv = bf2f(p.PROJ[(long)(ri.base + tt) * NIN + ch]); else xv = ri.sample ? p.state_lru_conv[((long)(ri.s * 2 + e) * 3 + (3 + tt)) * 512 + ch] : 0.f;
            acc += p.conv_a_w[(e * 4 + j) * 512 + ch] * xv; }
        p.sA[g] = acc;
        if (ri.t >= ri.T - 3) { float xv = bf2f(p.PROJ[(long)row * NIN + ch]); int j = ri.t - (ri.T - 3);
            p.out[(ri.sample ? O_CAS : O_CAP) + ((long)(ri.s * 2 + e) * 3 + j) * 512 + ch] = xv; } } };
struct FE2 { P p; int e, r0;
    HD void operator()(long g) const { int row = r0 + (int)(g / 512), ch = (int)(g % 512), g8 = ch >> 6, jj = ch & 63; RowInfo ri = rowinfo(row);
        const float* xc = p.sA + (long)(row - r0) * 512 + g8 * 64; const float* wa = p.lru_wa + (long)((e * 8 + g8) * 64) * 64 + jj; const float* wx = p.lru_wx + (long)((e * 8 + g8) * 64) * 64 + jj;
        float rp = p.lru_ba[e * 512 + ch], ip = p.lru_bx[e * 512 + ch];
        for (int i = 0; i < 64; ++i) { rp += xc[i] * wa[i * 64]; ip += xc[i] * wx[i * 64]; }
        float r = sigmoidf_(rp), ii = sigmoidf_(ip), sp = log1pf(expf(-p.lru_lam[e * 512 + ch]));
        float la = -8.0f * r * sp, a = expf(la), mult = sqrtf(-expm1f(2.0f * la));
        if (!ri.sample && ri.t == 0) mult = 1.0f;
        p.sB[g] = a; p.sC[g] = mult * (ii * xc[jj]); } };
struct FE3 { P p; int e, r0, T, sample;
    HD void operator()(long g) const { int si = (int)(g / 512), ch = (int)(g % 512); int rowb = r0 + si * T;
        float h = sample ? p.state_lru_h[(long)(si * 2 + e) * 512 + ch] : 0.f;
        for (int t = 0; t < T; ++t) { long idx = (long)(rowb - r0 + t) * 512 + ch; h = p.sB[idx] * h + p.sC[idx];
            float ga = bf2f(p.PROJ[(long)(rowb + t) * NIN + 512 + ch]); p.Y[(long)(rowb + t) * DM + ch] = f2bf(h * geluf_(ga)); }
        int s = sample ? si : r0 / SEQ;
        p.out[(sample ? O_HS : O_HP) + (long)(s * 2 + e) * 512 + ch] = h; } };
struct FE4 { P p; int e, r0;
    HD void operator()(long g) const { int row = r0 + (int)(g / 512), ch = (int)(g % 512); RowInfo ri = rowinfo(row);
        float zb = 0.f, cur = 0.f;
        for (int j = 0; j < 3; ++j) { int tt = ri.t - 2 + j; float cx;
            if (tt >= 0) cx = bf2f(p.PROJ[(long)(ri.base + tt) * NIN + 1536 + ch]) * bf2f(p.PROJ[(long)(ri.base + tt) * NIN + 2048 + ch]);
            else cx = ri.sample ? p.state_sconv[((long)(ri.s * 2 + e) * 2 + (2 + tt)) * 512 + ch] : 0.f;
            zb += p.conv_b_w[(e * 3 + j) * 512 + ch] * cx; cur = cx; }
        p.Y[(long)row * DM + 512 + ch] = f2bf(bf2f(p.PROJ[(long)row * NIN + 1024 + ch]) * zb);
        if (ri.t >= ri.T - 2) p.out[(ri.sample ? O_SCS : O_SCP) + ((long)(ri.s * 2 + e) * 2 + (ri.t - (ri.T - 2))) * 512 + ch] = cur; } };

struct FO1 { P p; int r0, pad_;
    HD void operator()(long g) const { int row = r0 + (int)(g / 128), hh = (int)((g % 128) / 32), i = (int)(g % 32); RowInfo ri = rowinfo(row);
        int pi = ri.sample ? SEQ + ri.t : ri.t; float c = p.rope[(pi * 32 + i) * 2], s = p.rope[(pi * 32 + i) * 2 + 1];
        const bf16* pr = p.PROJ + (long)row * NIN; long o = (long)(row - r0) * 256 + hh * 64 + i;
        float q1 = bf2f(pr[hh * 64 + i]), q2 = bf2f(pr[hh * 64 + 32 + i]); p.sA[o] = q1 * c - q2 * s; p.sA[o + 32] = q1 * s + q2 * c;
        float k1 = bf2f(pr[256 + hh * 64 + i]), k2 = bf2f(pr[256 + hh * 64 + 32 + i]); p.sB[o] = 0.125f * (k1 * c - k2 * s); p.sB[o + 32] = 0.125f * (k1 * s + k2 * c); } };
struct FO2 { P p; int b, pad_;
    HD void operator()(long g) const { int e = (int)(g % 128), d = (int)((g / 128) % 64), hh = (int)((g / 8192) % 4), c = (int)(g / 32768);
        float acc = 0.f;
        for (int m = 0; m < 128; ++m) { int lr = c * 128 + m; acc += p.sB[(long)lr * 256 + hh * 64 + d] * gpow(hh, 127 - m) * bf2f(p.PROJ[(long)(b * SEQ + lr) * NIN + 512 + hh * 128 + e]); }
        p.sD[g] = acc; } };
struct FO3 { P p; int b, o;
    HD void operator()(long g) const { int hh = (int)(g / 8192); float S = 0.f, g128 = gpow(hh, 128);
        for (int c = 0; c < NC; ++c) { long i = (long)c * 32768 + g; p.sE[i] = S; S = g128 * S + p.sD[i]; }
        p.out[O_RP + (long)((b * 2 + o) * 4) * 8192 + g] = S; } };
struct FO4 { P p;
    HD void operator()(long g) const { int m = (int)(g % 128), l = (int)((g / 128) % 128), hh = (int)((g / 16384) % 4), c = (int)(g / 65536);
        float v = 0.f;
        if (m <= l) { const float* q = p.sA + (long)(c * 128 + l) * 256 + hh * 64; const float* k = p.sB + (long)(c * 128 + m) * 256 + hh * 64; float dot = 0.f; for (int d = 0; d < 64; ++d) dot += q[d] * k[d]; v = dot * gpow(hh, l - m); }
        p.sF[g] = v; } };
struct FO5 { P p; int b, pad_;
    HD void operator()(long g) const { int e = (int)(g % 128), l = (int)((g / 128) % 128), hh = (int)((g / 16384) % 4), c = (int)(g / 65536);
        const float* pm = p.sF + (long)(c * 4 + hh) * 16384 + l * 128; float acc = 0.f;
        for (int m = 0; m <= l; ++m) acc += pm[m] * bf2f(p.PROJ[(long)(b * SEQ + c * 128 + m) * NIN + 512 + hh * 128 + e]);
        const float* q = p.sA + (long)(c * 128 + l) * 256 + hh * 64; const float* s0 = p.sE + (long)(c * 4 + hh) * 8192 + e; float cr = 0.f; for (int d = 0; d < 64; ++d) cr += q[d] * s0[d * 128];
        p.sC[(long)(c * 128 + l) * 512 + hh * 128 + e] = acc + gpow(hh, l + 1) * cr; } };
struct FO5s { P p; int o, pad_;
    HD void operator()(long g) const { int e = (int)(g % 128), hh = (int)((g / 128) % 4), l = (int)((g / 512) % 4), n = (int)(g / 2048);
        const float* q = p.sA + (long)(n * 4 + l) * 256 + hh * 64; float acc = 0.f;
        for (int m = 0; m <= l; ++m) { const float* k = p.sB + (long)(n * 4 + m) * 256 + hh * 64; float dot = 0.f; for (int d = 0; d < 64; ++d) dot += q[d] * k[d];
            acc += gpow(hh, l - m) * dot * bf2f(p.PROJ[(long)(MP + n * 4 + m) * NIN + 512 + hh * 128 + e]); }
        const float* s0 = p.state_ret + (long)((n * 2 + o) * 4 + hh) * 8192 + e; float cr = 0.f; for (int d = 0; d < 64; ++d) cr += q[d] * s0[d * 128];
        p.sC[(long)(n * 4 + l) * 512 + hh * 128 + e] = acc + gpow(hh, l + 1) * cr; } };
struct FO3s { P p; int o, pad_;
    HD void operator()(long g) const { int e = (int)(g % 128), d = (int)((g / 128) % 64), hh = (int)((g / 8192) % 4), n = (int)(g / 32768);
        long si = (long)((n * 2 + o) * 4 + hh) * 8192 + d * 128 + e; float S = gpow(hh, 4) * p.state_ret[si];
        for (int l = 0; l < 4; ++l) S += gpow(hh, 3 - l) * p.sB[(long)(n * 4 + l) * 256 + hh * 64 + d] * bf2f(p.PROJ[(long)(MP + n * 4 + l) * NIN + 512 + hh * 128 + e]);
        p.out[O_RS + si] = S; } };
struct FO6 { P p; int o, r0;
    HD void operator()(long g) const { int row = r0 + (int)(g / 4), hh = (int)(g % 4); const float* ov = p.sC + (long)(row - r0) * 512 + hh * 128;
        float mu = 0.f; for (int e = 0; e < 128; ++e) mu += ov[e]; mu *= (1.0f / 128); float var = 0.f; for (int e = 0; e < 128; ++e) { float d = ov[e] - mu; var += d * d; } var *= (1.0f / 128);
        float rs = 1.0f / sqrtf(var + LN_EPS);
        for (int e = 0; e < 128; ++e) { float gt = bf2f(p.PROJ[(long)row * NIN + 1024 + hh * 128 + e]); p.Y[(long)row * DM + hh * 128 + e] = f2bf(siluf_(gt) * ((ov[e] - mu) * rs) * p.ret_gn_g[o * 512 + hh * 128 + e]); } } };
struct FO7 { P p; int o, r0;
    HD void operator()(long g) const { int row = r0 + (int)g; const bf16* pr = p.PROJ + (long)row * NIN + 2048; float* vd = p.sB + g * 512;
        float mu = 0.f; for (int c = 0; c < 512; ++c) { float v = geluf_(bf2f(pr[c])); vd[c] = v; mu += v; } mu *= (1.0f / 512);
        float var = 0.f; for (int c = 0; c < 512; ++c) { float d = vd[c] - mu; var += d * d; } var *= (1.0f / 512); float rs = 1.0f / sqrtf(var + LN_EPS);
        RowInfo ri = rowinfo(row);
        for (int c = 0; c < 512; ++c) { float v = (vd[c] - mu) * rs * p.gm_ln_g[o * 512 + c] + p.gm_ln_b[o * 512 + c]; vd[c] = v;
            if (ri.sample) p.out[O_CV + ((long)(ri.s * 2 + o) * 4 + ri.t) * 512 + c] = v; } } };
struct FO8 { P p; int o, r0;
    HD void operator()(long g) const { int row = r0 + (int)(g / 512), ch = (int)(g % 512), gg = ch >> 7; RowInfo ri = rowinfo(row);
        int tl = ri.sample ? ri.t : (ri.t & 127), cb = row - tl;
        float s = p.sp_b[(o * 4 + gg) * 128 + tl]; const float* w = p.sp_w + ((long)(o * 4 + gg) * 128 + tl) * 128;
        for (int s2 = 0; s2 <= tl; ++s2) s += w[s2] * p.sB[(long)(cb + s2 - r0) * 512 + ch];
        p.Y[(long)row * DM + 512 + ch] = f2bf(geluf_(bf2f(p.PROJ[(long)row * NIN + 1536 + ch])) * s); } };
template <class B> void forward(B& be, P& p) {
    for (int l = 0; l < DEPTH; ++l) {
        const float* win = (l % 2 == 0 ? p.w_in_even : p.w_in_odd) + (long)(l / 2) * DM * NIN;
        const float* wout = (l % 2 == 0 ? p.w_out_even : p.w_out_odd) + (long)(l / 2) * DM * DM;
        be.run(FPrepW{win, p.Wt_in + (long)l * NIN * DM, DM, NIN}, (long)NIN * DM);
        be.run(FPrepW{wout, p.Wt_out + (long)l * DM * DM, DM, DM}, (long)DM * DM);
        be.run(FPrepW13{p.ffn_w1 + (long)l * DM * DFF, p.ffn_w3 + (long)l * DM * DFF, p.Wt_13 + (long)l * 2 * DFF * DM}, (long)2 * DFF * DM);
        be.run(FPrepW{p.ffn_w2 + (long)l * DFF * DM, p.Wt_2 + (long)l * DM * DFF, DFF, DM}, (long)DM * DFF);
    }
    be.run(FPrepX{p}, (long)M * DM);
    be.run(FRope{p.rope}, (long)(SEQ + 4) * 32);
    for (int l = 0; l < DEPTH; ++l) {
        be.gemm_proj(l);
        for (int grp = 0; grp <= BATCH; ++grp) {
            const int sample = grp == BATCH, r0 = sample ? MP : grp * SEQ, nr = sample ? MS : SEQ, T = sample ? DECS : SEQ, nseq = sample ? DECB : 1;
            if (l % 2 == 0) { const int e = l / 2;
                be.run(FE1{p, e, r0}, (long)nr * 512); be.run(FE2{p, e, r0}, (long)nr * 512); be.run(FE3{p, e, r0, T, sample}, (long)nseq * 512); be.run(FE4{p, e, r0}, (long)nr * 512);
            } else { const int o = l / 2;
                be.run(FO1{p, r0}, (long)nr * 128);
                if (!sample) { be.run(FO2{p, grp}, (long)NC * 32768); be.run(FO3{p, grp, o}, 32768L); be.run(FO4{p}, (long)NC * 65536); be.run(FO5{p, grp}, (long)NC * 65536); }
                else { be.run(FO5s{p, o}, (long)DECB * 2048); be.run(FO3s{p, o}, (long)DECB * 32768); }
                be.run(FO6{p, o, r0}, (long)nr * 4); be.run(FO7{p, o, r0}, (long)nr); be.run(FO8{p, o, r0}, (long)nr * 512);
            }
        }
        be.gemm_out(l); be.run(FLN{p, p.ln1_g + l * DM, p.ln1_b + l * DM}, (long)M);
        be.gemm_13(l); be.gemm_2(l); be.run(FLN{p, p.ln2_g + l * DM, p.ln2_b + l * DM}, (long)M);
    }
}
namespace pg8 {
#define PG8_LAS __attribute__((address_space(3)))
typedef unsigned short bf16_t;
typedef short bf16x8 __attribute__((ext_vector_type(8)));
typedef float f32x4 __attribute__((ext_vector_type(4)));
typedef unsigned u32x4 __attribute__((ext_vector_type(4)));
constexpr int BM = 256, BK = 64, HALF = 128, HTB = HALF * BK * 2  , STAGE_BYTES = 8 * HTB, NXCD = 8, WGM = 8;

__host__ __device__ __forceinline__ int lds_byte(int r, int c) { const int st = (r >> 4) * 2 + (c >> 5), rr = r & 15, cc = c & 31, ob = rr * 64 + cc * 2; return st * 1024 + (ob ^ (((ob >> 9) & 1) << 5)); }
__host__ __device__ __forceinline__ void stage_rc(int b, int& R, int& C) { const int st = b / 1024, sb = b % 1024, swz = sb ^ (((sb >> 9) & 1) << 5); R = (st >> 1) * 16 + swz / 64; C = (st & 1) * 32 + (swz % 64) / 2; }
__host__ __device__ __forceinline__ int perm32(int rho) { const int n = rho >> 4, i = rho & 15; return 8 * (i >> 2) + 4 * n + (i & 3); }

struct Unit { int pm, pn; };
struct Gemm { const bf16_t* A; const bf16_t* Bt; int M, N, K; };

struct StaticOrder {
    int nM, nN, nwg, G, c;
    __host__ __device__ void init(int M, int N, int G_, int c_) { nM = M / BM; nN = N / BM; nwg = nM * nN; G = G_; c = c_; }
    __host__ __device__ bool next(int i, Unit& u) const {
        const long L = (long)i * G + c; if (L >= nwg) return false;
        int wgid = (int)L; { const int q = nwg / NXCD, r = nwg % NXCD, xcd = wgid % NXCD, off = wgid / NXCD; wgid = (xcd < r ? xcd * (q + 1) : r * (q + 1) + (xcd - r) * q) + off; }
        const int nig = WGM * nN, gid = wgid / nig, fm = gid * WGM, gsz = (nM - fm) < WGM ? (nM - fm) : WGM;
        u.pm = fm + ((wgid % nig) % gsz); u.pn = (wgid % nig) / gsz; return true;
    }
    __device__ __forceinline__ void a_ready(const Unit&) const {}
    __device__ __forceinline__ void done(const Unit&) const {}
};

__device__ __forceinline__ unsigned cvt_pk_bf16(float lo, float hi) { unsigned r; asm volatile("v_cvt_pk_bf16_f32 %0, %1, %2" : "=v"(r) : "v"(lo), "v"(hi)); return r; }
struct EpiProj {
    static constexpr bool PERM = true, AFTER_DRAIN = false;
    bf16_t* O; int ldc;
    __device__ __forceinline__ void operator()(const f32x4 (&acc)[2][2][4][2], const Unit& u, int wr, int wc, int fr, int fq) const {
        const int row0 = u.pm * BM + wr * 64 + fr, col0 = u.pn * BM + wc * 32 + 8 * fq;
#pragma unroll
        for (int ai = 0; ai < 2; ++ai)
#pragma unroll
            for (int m = 0; m < 4; ++m) { bf16_t* rowp = O + (size_t)(row0 + ai * HALF + m * 16) * ldc + col0;
#pragma unroll
                for (int bj = 0; bj < 2; ++bj) { const f32x4 v0 = acc[ai][bj][m][0], v1 = acc[ai][bj][m][1];
                    u32x4 w; w.x = cvt_pk_bf16(v0[0], v0[1]); w.y = cvt_pk_bf16(v0[2], v0[3]); w.z = cvt_pk_bf16(v1[0], v1[1]); w.w = cvt_pk_bf16(v1[2], v1[3]);
                    *(u32x4*)(rowp + bj * HALF) = w; } }
    }
};
__device__ __forceinline__ float silu_f(float x) { return x / (1.0f + __expf(-x)); }
struct EpiSwiglu {
    static constexpr bool PERM = true, AFTER_DRAIN = false;
    bf16_t* O; int ldc;
    __device__ __forceinline__ void operator()(const f32x4 (&acc)[2][2][4][2], const Unit& u, int wr, int wc, int fr, int fq) const {
        const int row0 = u.pm * BM + wr * 64 + fr, col0 = u.pn * HALF + wc * 32 + 8 * fq;
#pragma unroll
        for (int ai = 0; ai < 2; ++ai)
#pragma unroll
            for (int m = 0; m < 4; ++m) { bf16_t* rowp = O + (size_t)(row0 + ai * HALF + m * 16) * ldc + col0;
                float h[8];
#pragma unroll
                for (int n = 0; n < 2; ++n)
#pragma unroll
                    for (int i = 0; i < 4; ++i) h[n * 4 + i] = silu_f(acc[ai][0][m][n][i]) * acc[ai][1][m][n][i];
                u32x4 w; w.x = cvt_pk_bf16(h[0], h[1]); w.y = cvt_pk_bf16(h[2], h[3]); w.z = cvt_pk_bf16(h[4], h[5]); w.w = cvt_pk_bf16(h[6], h[7]);
                *(u32x4*)rowp = w; }
    }
};
struct EpiRes {
    static constexpr bool PERM = false, AFTER_DRAIN = false;
    float* X; int ldc; float alpha;
    __device__ __forceinline__ void operator()(const f32x4 (&acc)[2][2][4][2], const Unit& u, int wr, int wc, int fr, int fq) const {
        const int row0 = u.pm * BM + wr * 64 + fr, col0 = u.pn * BM + wc * 32 + 4 * fq;
#pragma unroll
        for (int ai = 0; ai < 2; ++ai)
#pragma unroll
            for (int m = 0; m < 4; ++m) { float* rowp = X + (size_t)(row0 + ai * HALF + m * 16) * ldc + col0;
#pragma unroll
                for (int bj = 0; bj < 2; ++bj)
#pragma unroll
                    for (int n = 0; n < 2; ++n) { f32x4* q = (f32x4*)(rowp + bj * HALF + n * 16); *q = *q * alpha + acc[ai][bj][m][n]; } }
    }
};
template <class Epi, class Sched, bool ALIGN_EPI = false, bool SP2 = false>
__device__ __forceinline__ void gemm_phase(PG8_LAS unsigned char* lds, const Gemm g, const Sched& S, const Epi& E) {
    const int tid = threadIdx.x, wid = __builtin_amdgcn_readfirstlane(tid >> 6), lane = tid & 63, wr = wid >> 2, wc = wid & 3, fr = lane & 15, fq = lane >> 4;
    const int K = g.K, nt = K / BK;
    unsigned voffA[2], voffB[2];
#pragma unroll
    for (int i = 0; i < 2; ++i) { int R, C; stage_rc(tid * 16 + i * 8192, R, C); const int Rb = Epi::PERM ? ((R & ~31) + perm32(R & 31)) : R;
        voffA[i] = (unsigned)(R * K + C) * 2u; voffB[i] = (unsigned)(Rb * K + C) * 2u; }
    const size_t kstep = (size_t)(BK * 2);
    const size_t hstep = (size_t)HALF * K * 2;
    const size_t tstep = 2 * hstep;
    const unsigned ldsw = (unsigned)wid * 1024u;
    const int aoff = lds_byte(wr * 64 + fr, fq * 8), boff = lds_byte(wc * 32 + fr, fq * 8);
#define PG8_SA(b, h) (((b) * 2 + (h)) * HTB)
#define PG8_SB(b, h) ((4 + (b) * 2 + (h)) * HTB)
#define PG8_STAGE(bufoff, gbase, voff) do { _Pragma("unroll") for (int _i = 0; _i < 2; ++_i) \
        __builtin_amdgcn_global_load_lds((const unsigned*)((const char*)(gbase) + (voff)[_i]), (PG8_LAS unsigned*)(lds + (bufoff) + ldsw + _i * 8192), 16, 0, 0); } while (0)
#define PG8_LDA(dst, b, h) do { _Pragma("unroll") for (int m = 0; m < 4; ++m) _Pragma("unroll") for (int k = 0; k < 2; ++k) dst[m][k] = *(const PG8_LAS bf16x8*)(lds + PG8_SA(b, h) + aoff + m * 2048 + k * 1024); } while (0)
#define PG8_LDB(dst, b, h) do { _Pragma("unroll") for (int n = 0; n < 2; ++n) _Pragma("unroll") for (int k = 0; k < 2; ++k) dst[n][k] = *(const PG8_LAS bf16x8*)(lds + PG8_SB(b, h) + boff + n * 2048 + k * 1024); } while (0)
#define PG8_MMA(ai, bj, At, Bt) do { __builtin_amdgcn_s_setprio(1); _Pragma("unroll") for (int m = 0; m < 4; ++m) _Pragma("unroll") for (int n = 0; n < 2; ++n) _Pragma("unroll") for (int k = 0; k < 2; ++k) \
        acc[ai][bj][m][n] = __builtin_amdgcn_mfma_f32_16x16x32_bf16(Bt[n][k], At[m][k], acc[ai][bj][m][n], 0, 0, 0); __builtin_amdgcn_s_setprio(0); } while (0)
#define PG8_WAIT_V(n) asm volatile("s_waitcnt vmcnt(" #n ")" ::: "memory")
#define PG8_WAIT_L(n) asm volatile("s_waitcnt lgkmcnt(" #n ")" ::: "memory")
#define PG8_BAR __builtin_amdgcn_s_barrier()
#define PG8_SCHED __builtin_amdgcn_sched_barrier(0)
    Unit cur, nxt; int ui = 0;
    if (!S.next(0, cur)) return;
    f32x4 acc[2][2][4][2];
#pragma unroll
    for (int a = 0; a < 2; ++a)
#pragma unroll
        for (int b = 0; b < 2; ++b)
#pragma unroll
            for (int m = 0; m < 4; ++m)
#pragma unroll
                for (int n = 0; n < 2; ++n) acc[a][b][m][n] = (f32x4){0.f, 0.f, 0.f, 0.f};
    bf16x8 At[4][2], B0[2][2], B1[2][2];
    const char* cA = (const char*)g.A + (size_t)cur.pm * tstep; const char* cB = (const char*)g.Bt + (size_t)cur.pn * tstep;
    S.a_ready(cur);
    if constexpr (SP2) {
        PG8_STAGE(PG8_SB(0, 0), cB, voffB); PG8_STAGE(PG8_SB(0, 1), cB + hstep, voffB); PG8_STAGE(PG8_SA(0, 0), cA, voffA); PG8_STAGE(PG8_SA(0, 1), cA + hstep, voffA);
        if (wr == 1) PG8_BAR;
        PG8_WAIT_V(2); PG8_BAR;
        PG8_STAGE(PG8_SB(1, 0), cB + kstep, voffB); PG8_STAGE(PG8_SA(1, 0), cA + kstep, voffA); PG8_STAGE(PG8_SB(1, 1), cB + hstep + kstep, voffB);
        PG8_WAIT_V(6); PG8_BAR;
    } else {
        PG8_STAGE(PG8_SB(0, 0), cB, voffB); PG8_STAGE(PG8_SA(0, 0), cA, voffA); PG8_STAGE(PG8_SB(0, 1), cB + hstep, voffB); PG8_STAGE(PG8_SA(0, 1), cA + hstep, voffA);
        if (wr == 1) PG8_BAR;
        PG8_WAIT_V(4); PG8_BAR;
        PG8_STAGE(PG8_SB(1, 0), cB + kstep, voffB); PG8_STAGE(PG8_SA(1, 0), cA + kstep, voffA); PG8_STAGE(PG8_SB(1, 1), cB + hstep + kstep, voffB);
        PG8_WAIT_V(6); PG8_BAR;
    }
    for (;;) {
        const bool has_next = S.next(ui + 1, nxt);
        const char* nA = has_next ? (const char*)g.A + (size_t)nxt.pm * tstep : cA; const char* nB = has_next ? (const char*)g.Bt + (size_t)nxt.pn * tstep : cB;
        for (int t = 0; t < nt; t += 2) {
            const bool last = (t == nt - 2);
            const char* a1 = cA + (size_t)(t + 1) * kstep;
            const char* a2 = last ? nA : cA + (size_t)(t + 2) * kstep; const char* b2 = last ? nB : cB + (size_t)(t + 2) * kstep;
            const char* a3 = a2 + kstep; const char* b3 = b2 + kstep;
            if (last && has_next) S.a_ready(nxt);
            if constexpr (SP2) {
            PG8_LDB(B0, 0, 0); PG8_LDB(B1, 0, 1); PG8_SCHED; PG8_LDA(At, 0, 0); PG8_STAGE(PG8_SA(1, 1), a1 + hstep, voffA);
            PG8_WAIT_V(8); PG8_WAIT_L(0); PG8_BAR; PG8_MMA(0, 0, At, B0); PG8_MMA(0, 1, At, B1); PG8_BAR; PG8_SCHED;
            PG8_LDA(At, 0, 1); PG8_STAGE(PG8_SB(0, 0), b2, voffB); PG8_STAGE(PG8_SB(0, 1), b2 + hstep, voffB); PG8_STAGE(PG8_SA(0, 0), a2, voffA);
            PG8_WAIT_V(8); PG8_WAIT_L(0); PG8_BAR; PG8_MMA(1, 0, At, B0); PG8_MMA(1, 1, At, B1); PG8_BAR; PG8_SCHED;
            PG8_LDB(B0, 1, 0); PG8_LDB(B1, 1, 1); PG8_SCHED; PG8_LDA(At, 1, 0); PG8_STAGE(PG8_SA(0, 1), a2 + hstep, voffA);
            PG8_WAIT_V(8); PG8_WAIT_L(0); PG8_BAR; PG8_MMA(0, 0, At, B0); PG8_MMA(0, 1, At, B1); PG8_BAR; PG8_SCHED;
            PG8_LDA(At, 1, 1); PG8_STAGE(PG8_SB(1, 0), b3, voffB); PG8_STAGE(PG8_SB(1, 1), b3 + hstep, voffB); PG8_STAGE(PG8_SA(1, 0), a3, voffA);
            PG8_WAIT_V(8); PG8_WAIT_L(0); PG8_BAR; PG8_MMA(1, 0, At, B0); PG8_MMA(1, 1, At, B1); PG8_BAR; PG8_SCHED;
            } else {
            PG8_LDB(B0, 0, 0); PG8_SCHED; PG8_LDA(At, 0, 0); PG8_STAGE(PG8_SA(1, 1), a1 + hstep, voffA);
            PG8_WAIT_L(8); PG8_BAR; PG8_WAIT_L(0); PG8_MMA(0, 0, At, B0); PG8_BAR; PG8_SCHED;
            PG8_LDB(B1, 0, 1); PG8_STAGE(PG8_SB(0, 0), b2, voffB);
            PG8_BAR; PG8_WAIT_L(0); PG8_MMA(0, 1, At, B1); PG8_BAR;
            PG8_LDA(At, 0, 1); PG8_STAGE(PG8_SA(0, 0), a2, voffA);
            PG8_BAR; PG8_WAIT_L(0); PG8_MMA(1, 0, At, B0); PG8_BAR; PG8_SCHED;
            PG8_STAGE(PG8_SB(0, 1), b2 + hstep, voffB);
            PG8_WAIT_V(6); PG8_BAR; PG8_MMA(1, 1, At, B1); PG8_BAR;
            PG8_LDB(B0, 1, 0); PG8_SCHED; PG8_LDA(At, 1, 0); PG8_STAGE(PG8_SA(0, 1), a2 + hstep, voffA);
            PG8_WAIT_L(8); PG8_BAR; PG8_WAIT_L(0); PG8_MMA(0, 0, At, B0); PG8_BAR; PG8_SCHED;
            PG8_LDB(B1, 1, 1); PG8_STAGE(PG8_SB(1, 0), b3, voffB);
            PG8_BAR; PG8_WAIT_L(0); PG8_MMA(0, 1, At, B1); PG8_BAR;
            PG8_LDA(At, 1, 1); PG8_STAGE(PG8_SA(1, 0), a3, voffA);
            PG8_BAR; PG8_WAIT_L(0); PG8_MMA(1, 0, At, B0); PG8_BAR; PG8_SCHED;
            PG8_STAGE(PG8_SB(1, 1), b3 + hstep, voffB);
            PG8_WAIT_V(6); PG8_BAR; PG8_MMA(1, 1, At, B1); PG8_BAR;
            }
        }
        if constexpr (ALIGN_EPI) { if (wr == 0) PG8_BAR; }
        if constexpr (!Epi::AFTER_DRAIN) { E(acc, cur, wr, wc, fr, fq); S.done(cur); }
        if (!has_next) break;
#pragma unroll
        for (int a = 0; a < 2; ++a)
#pragma unroll
            for (int b = 0; b < 2; ++b)
#pragma unroll
                for (int m = 0; m < 4; ++m)
#pragma unroll
                    for (int n = 0; n < 2; ++n) acc[a][b][m][n] = (f32x4){0.f, 0.f, 0.f, 0.f};
        cur = nxt; cA = nA; cB = nB; ++ui;
        if constexpr (ALIGN_EPI) { if (wr == 1) PG8_BAR; }
    }
    PG8_WAIT_V(0);
    if constexpr (!ALIGN_EPI) { if (wr == 0) PG8_BAR; }
    PG8_BAR;
    if constexpr (Epi::AFTER_DRAIN) { E.fused(acc, cur, wr, wc, fr, fq, lds, wid, lane); S.done(cur); }
#undef PG8_SA
#undef PG8_SB
#undef PG8_STAGE
#undef PG8_LDA
#undef PG8_LDB
#undef PG8_MMA
#undef PG8_WAIT_V
#undef PG8_WAIT_L
#undef PG8_BAR
#undef PG8_SCHED
}
}
template <class F> __global__ void __launch_bounds__(256) k_simple(F f, long n) {
    for (long g = (long)blockIdx.x * blockDim.x + threadIdx.x; g < n; g += (long)gridDim.x * blockDim.x) f(g);
}
template <class Epi> __global__ void __launch_bounds__(512, 2) k_gemm(pg8::Gemm g, Epi E) {
    extern __shared__ __attribute__((aligned(16))) unsigned char lds[];
    pg8::StaticOrder S; S.init(g.M, g.N, (int)gridDim.x, (int)blockIdx.x);
    pg8::gemm_phase<Epi, pg8::StaticOrder, true, true>((PG8_LAS unsigned char*)lds, g, S, E);
}
struct GpuBackend { P p; hipStream_t st;
    template <class F> void run(F f, long n) { long nb = (n + 255) / 256; if (nb > 8192) nb = 8192; hipLaunchKernelGGL(k_simple<F>, dim3((unsigned)nb), dim3(256), 0, st, f, n); }
    template <class Epi> void gemm(const bf16* A, const bf16* Bt, int N, int K, Epi E) {
        static bool attr = false; if (!attr) { (void)hipFuncSetAttribute((const void*)k_gemm<Epi>, hipFuncAttributeMaxDynamicSharedMemorySize, pg8::STAGE_BYTES); attr = true; }
        pg8::Gemm g{A, Bt, M, N, K}; hipLaunchKernelGGL(k_gemm<Epi>, dim3(256), dim3(512), pg8::STAGE_BYTES, st, g, E);
    }
    void gemm_proj(int l) { gemm(p.XB, p.Wt_in + (long)l * NIN * DM, NIN, DM, pg8::EpiProj{p.PROJ, NIN}); }
    void gemm_out(int l) { gemm(p.Y, p.Wt_out + (long)l * DM * DM, DM, DM, pg8::EpiRes{p.XF, DM, ALPHA}); }
    void gemm_13(int l) { gemm(p.XB, p.Wt_13 + (long)l * 2 * DFF * DM, 2 * DFF, DM, pg8::EpiSwiglu{p.H, DFF}); }
    void gemm_2(int l) { gemm(p.H, p.Wt_2 + (long)l * DM * DFF, DM, DFF, pg8::EpiRes{p.XF, DM, ALPHA}); }
};
extern "C" void kernel_launch(void* const* d_in, const int* in_sizes, int n_in, void* d_out, int out_size, void* d_ws, size_t ws_size, hipStream_t stream) {
    if (n_in != 30 || (long)out_size != O_END || ws_size < WS_END) { fprintf(stderr, "kernel_launch: unexpected shapes n_in %d out %d (want %ld) ws %zu (want %zu)\n", n_in, out_size, O_END, ws_size, (size_t)WS_END); return; }
    GpuBackend be{}; setup_P(be.p, d_in, d_out, d_ws); be.st = stream;
    forward(be, be.p);
}
```

```cpp
#include <hip/hip_runtime.h>
#include <cstdio>
#include <cstdint>
#define HD __host__ __device__ __forceinline__
#define CONSTAS __attribute__((address_space(4)))
#ifndef T_BATCH
#define T_BATCH 8
#endif
#ifndef T_SEQ
#define T_SEQ 2048
#endif
#ifndef T_DEC
#define T_DEC 128
#endif
typedef unsigned short bf16;
#ifndef CONSTAS
#define CONSTAS
#endif
#define PREF const CONSTAS P&
constexpr int BATCH = T_BATCH, SEQ = T_SEQ, DECB = T_DEC, DECS = 4, DM = 1024, DEPTH = 4;
constexpr int NIN = 2560, DFF = 2816, NC = SEQ / 128, PAST = 16384;
constexpr int MP = BATCH * SEQ, MS = DECB * DECS, M = MP + MS;
constexpr float ALPHA = 1.681792830507429f, LN_EPS = 1e-5f;
constexpr long O_Y = 0, O_HP = (long)M * DM, O_HS = O_HP + (long)BATCH * 1024, O_CAP = O_HS + (long)DECB * 1024, O_CAS = O_CAP + (long)BATCH * 3072,
               O_SCP = O_CAS + (long)DECB * 3072, O_SCS = O_SCP + (long)BATCH * 2048, O_RP = O_SCS + (long)DECB * 2048, O_RS = O_RP + (long)BATCH * 65536,
               O_CV = O_RS + (long)DECB * 65536, O_END = O_CV + (long)DECB * 4096;
constexpr size_t al256(size_t x) { return (x + 255) & ~(size_t)255; }
constexpr size_t WS_CTL = 0, WS_WIN = 1u << 20, WS_WOUT = WS_WIN + (size_t)4 * NIN * DM * 2, WS_W13 = WS_WOUT + (size_t)4 * DM * DM * 2,
                 WS_W2 = WS_W13 + (size_t)4 * 2 * DFF * DM * 2, WS_XB = WS_W2 + (size_t)4 * DM * DFF * 2, WS_PROJ = al256(WS_XB + (size_t)M * DM * 2),
                 WS_Y = al256(WS_PROJ + (size_t)M * NIN * 2), WS_ROPE = al256(WS_Y + (size_t)M * DM * 2), WS_WAT = al256(WS_ROPE + (size_t)(SEQ + 4) * 64 * 4), WS_WXT = WS_WAT + 131072, WS_AP = WS_WXT + 131072,
                 WS_HE = WS_AP + (size_t)BATCH * (SEQ / 64) * 512 * 4, WS_WTRIL = WS_HE + (size_t)BATCH * (SEQ / 64) * 512 * 4, WS_KVT = WS_WTRIL + (size_t)2 * 4 * 128 * 128 * 2,
                 WS_SCR = al256(WS_KVT + (size_t)BATCH * NC * 4 * 8192 * 4);
constexpr size_t WS_H = WS_PROJ;
static_assert((size_t)M * DFF * 2 <= WS_ROPE - WS_PROJ, "H overlay");
constexpr int GR = (SEQ > MS ? SEQ : MS);
constexpr size_t SCR_A = 0, SCR_B = SCR_A + (size_t)GR * 512 * 4, SCR_C = SCR_B + (size_t)GR * 512 * 4, SCR_D = SCR_C + (size_t)GR * 512 * 4,
                 SCR_E = SCR_D + (size_t)NC * 4 * 8192 * 4, SCR_F = SCR_E + (size_t)NC * 4 * 8192 * 4, SCR_END = SCR_F + (size_t)NC * 4 * 16384 * 4;
constexpr size_t WS_END = WS_SCR + SCR_END;

struct P {
    const float *x_prompt, *x_sample, *state_lru_h, *state_lru_conv, *state_sconv, *state_ret;
    const float *w_in_even, *conv_a_w, *conv_a_b, *lru_wa, *lru_ba, *lru_wx, *lru_bx, *lru_lam, *conv_b_w, *w_out_even;
    const float *w_in_odd, *ret_gn_g, *sp_w, *sp_b, *gm_ln_g, *gm_ln_b, *w_out_odd;
    const float *ffn_w1, *ffn_w3, *ffn_w2, *ln1_g, *ln1_b, *ln2_g, *ln2_b;
    float* out; unsigned char* ws;
    bf16 *Wt_in, *Wt_out, *Wt_13, *Wt_2, *XB, *PROJ, *Y, *H;
    float *XF, *rope, *sA, *sB, *sC, *sD, *sE, *sF;
    bf16 *WaT, *WxT, *Wtril; float *AP, *HE, *KVT;
};
static inline void setup_P(P& p, void* const* d_in, void* d_out, void* d_ws) {
    const float** f = (const float**)&p.x_prompt;
    for (int i = 0; i < 30; ++i) f[i] = (const float*)d_in[i];
    p.out = (float*)d_out; p.ws = (unsigned char*)d_ws;
    p.Wt_in = (bf16*)(p.ws + WS_WIN); p.Wt_out = (bf16*)(p.ws + WS_WOUT); p.Wt_13 = (bf16*)(p.ws + WS_W13); p.Wt_2 = (bf16*)(p.ws + WS_W2);
    p.XB = (bf16*)(p.ws + WS_XB); p.PROJ = (bf16*)(p.ws + WS_PROJ); p.Y = (bf16*)(p.ws + WS_Y); p.H = (bf16*)(p.ws + WS_H);
    p.XF = p.out; p.rope = (float*)(p.ws + WS_ROPE);
    p.WaT = (bf16*)(p.ws + WS_WAT); p.WxT = (bf16*)(p.ws + WS_WXT); p.Wtril = (bf16*)(p.ws + WS_WTRIL); p.AP = (float*)(p.ws + WS_AP); p.HE = (float*)(p.ws + WS_HE); p.KVT = (float*)(p.ws + WS_KVT);
    unsigned char* s = p.ws + WS_SCR;
    p.sA = (float*)(s + SCR_A); p.sB = (float*)(s + SCR_B); p.sC = (float*)(s + SCR_C); p.sD = (float*)(s + SCR_D); p.sE = (float*)(s + SCR_E); p.sF = (float*)(s + SCR_F);
}

HD bf16 f2bf(float f) { unsigned u = __builtin_bit_cast(unsigned, f); return (bf16)((u + 0x7fffu + ((u >> 16) & 1u)) >> 16); }
HD float bf2f(bf16 h) { return __builtin_bit_cast(float, (unsigned)h << 16); }
HD float sigmoidf_(float x) { return 1.0f / (1.0f + expf(-x)); }
HD float siluf_(float x) { return x * sigmoidf_(x); }
HD float geluf_(float x) { return 0.5f * x * (1.0f + tanhf(0.7978845608028654f * (x + 0.044715f * x * x * x))); }
HD float lgam(int h) { return h == 0 ? -0.0317486983145803f : h == 1 ? -0.015748356968139168f : h == 2 ? -0.007843177461025893f : -0.003913899321136329f; }
HD float gpow(int h, int n) { return expf((float)n * lgam(h)); }
struct RowInfo { int sample, s, t, T, base; };
HD RowInfo rowinfo(int row) { RowInfo r; if (row < MP) { r.sample = 0; r.s = row / SEQ; r.t = row % SEQ; r.T = SEQ; r.base = r.s * SEQ; } else { int q = row - MP; r.sample = 1; r.s = q / DECS; r.t = q % DECS; r.T = DECS; r.base = MP + r.s * DECS; } return r; }

struct FPrepW { const float* W; bf16* Wt; int K, N;
    HD void operator()(long g) const { int n = (int)(g / K), k = (int)(g % K); Wt[g] = f2bf(W[(long)k * N + n]); } };
struct FPrepW13 { const float* W; bf16* Wt; int half, pad_;
    HD void operator()(long g) const { int j = (int)(g / DM), k = (int)(g % DM); Wt[(long)((j >> 7) * 256 + half * 128 + (j & 127)) * DM + k] = f2bf(W[(long)k * DFF + j]); } };
struct FPrepX { PREF p;
    HD void operator()(long g) const { float v = g < (long)MP * DM ? p.x_prompt[g] : p.x_sample[g - (long)MP * DM]; p.XF[g] = v; p.XB[g] = f2bf(v); } };
struct FRope { float* cs;
    HD void operator()(long g) const { int pi = (int)(g / 32), i = (int)(g % 32); double pos = pi < SEQ ? (double)pi : (double)(PAST + pi - SEQ);
        double fr = 1.0; for (int j = 0; j < i; ++j) fr *= 0.7498942093324559;
        double ang = pos * fr, k = rint(ang * 0.15915494309189535), r = ang - k * 6.283185307179586; r -= k * 2.4492935982947064e-16;
        double r2 = r * r, sn = 0.0, cn = 0.0;
        for (int n = 14; n >= 1; --n) { sn = (sn + 1.0) * (-r2 / ((2.0 * n) * (2.0 * n + 1.0))); cn = (cn + 1.0) * (-r2 / ((2.0 * n - 1.0) * (2.0 * n))); }
        cs[2 * g] = (float)(cn + 1.0); cs[2 * g + 1] = (float)(r * (sn + 1.0)); } };

struct FLN { PREF p; const float* g; const float* b;
    HD void operator()(long row) const { float* z = p.XF + row * DM; float mu = 0.f; for (int c = 0; c < DM; ++c) mu += z[c]; mu *= (1.0f / DM);
        float var = 0.f; for (int c = 0; c < DM; ++c) { float d = z[c] - mu; var += d * d; } var *= (1.0f / DM); float rs = 1.0f / sqrtf(var + LN_EPS);
        for (int c = 0; c < DM; ++c) { float v = (z[c] - mu) * rs * g[c] + b[c]; z[c] = v; p.XB[row * DM + c] = f2bf(v); } } };

struct FE1 { PREF p; int e, r0;
    HD void operator()(long g) const { int row = r0 + (int)(g / 512), ch = (int)(g % 512); RowInfo ri = rowinfo(row);
        float acc = p.conv_a_b[e * 512 + ch];
        for (int j = 0; j < 4; ++j) { int tt = ri.t - 3 + j; float xv;
            if (tt >= 0) xv = bf2f(p.PROJ[(long)(ri.base + tt) * NIN + ch]); else xv = ri.sample ? p.state_lru_conv[((long)(ri.s * 2 + e) * 3 + (3 + tt)) * 512 + ch] : 0.f;
            acc += p.conv_a_w[(e * 4 + j) * 512 + ch] * xv; }
        p.sA[g] = acc;
        if (ri.t >= ri.T - 3) { float xv = bf2f(p.PROJ[(long)row * NIN + ch]); int j = ri.t - (ri.T - 3);
            p.out[(ri.sample ? O_CAS : O_CAP) + ((long)(ri.s * 2 + e) * 3 + j) * 512 + ch] = xv; } } };
struct FE2 { PREF p; int e, r0;
    HD void operator()(long g) const { int row = r0 + (int)(g / 512), ch = (int)(g % 512), g8 = ch >> 6, jj = ch & 63; RowInfo ri = rowinfo(row);
        const float* xc = p.sA + (long)(row - r0) * 512 + g8 * 64; const float* wa = p.lru_wa + (long)((e * 8 + g8) * 64) * 64 + jj; const float* wx = p.lru_wx + (long)((e * 8 + g8) * 64) * 64 + jj;
        float rp = p.lru_ba[e * 512 + ch], ip = p.lru_bx[e * 512 + ch];
        for (int i = 0; i < 64; ++i) { rp += xc[i] * wa[i * 64]; ip += xc[i] * wx[i * 64]; }
        float r = sigmoidf_(rp), ii = sigmoidf_(ip), sp = log1pf(expf(-p.lru_lam[e * 512 + ch]));
        float la = -8.0f * r * sp, a = expf(la), mult = sqrtf(-expm1f(2.0f * la));
        if (!ri.sample && ri.t == 0) mult = 1.0f;
        p.sB[g] = a; p.sC[g] = mult * (ii * xc[jj]); } };
struct FE3 { PREF p; int e, r0, T, sample;
    HD void operator()(long g) const { int si = (int)(g / 512), ch = (int)(g % 512); int rowb = r0 + si * T;
        float h = sample ? p.state_lru_h[(long)(si * 2 + e) * 512 + ch] : 0.f;
        for (int t = 0; t < T; ++t) { long idx = (long)(rowb - r0 + t) * 512 + ch; h = p.sB[idx] * h + p.sC[idx];
            float ga = bf2f(p.PROJ[(long)(rowb + t) * NIN + 512 + ch]); p.Y[(long)(rowb + t) * DM + ch] = f2bf(h * geluf_(ga)); }
        int s = sample ? si : r0 / SEQ;
        p.out[(sample ? O_HS : O_HP) + (long)(s * 2 + e) * 512 + ch] = h; } };
struct FE4 { PREF p; int e, r0;
    HD void operator()(long g) const { int row = r0 + (int)(g / 512), ch = (int)(g % 512); RowInfo ri = rowinfo(row);
        float zb = 0.f, cur = 0.f;
        for (int j = 0; j < 3; ++j) { int tt = ri.t - 2 + j; float cx;
            if (tt >= 0) cx = bf2f(p.PROJ[(long)(ri.base + tt) * NIN + 1536 + ch]) * bf2f(p.PROJ[(long)(ri.base + tt) * NIN + 2048 + ch]);
            else cx = ri.sample ? p.state_sconv[((long)(ri.s * 2 + e) * 2 + (2 + tt)) * 512 + ch] : 0.f;
            zb += p.conv_b_w[(e * 3 + j) * 512 + ch] * cx; cur = cx; }
        p.Y[(long)row * DM + 512 + ch] = f2bf(bf2f(p.PROJ[(long)row * NIN + 1024 + ch]) * zb);
        if (ri.t >= ri.T - 2) p.out[(ri.sample ? O_SCS : O_SCP) + ((long)(ri.s * 2 + e) * 2 + (ri.t - (ri.T - 2))) * 512 + ch] = cur; } };

struct FO1 { PREF p; int r0, pad_;
    HD void operator()(long g) const { int row = r0 + (int)(g / 128), hh = (int)((g % 128) / 32), i = (int)(g % 32); RowInfo ri = rowinfo(row);
        int pi = ri.sample ? SEQ + ri.t : ri.t; float c = p.rope[(pi * 32 + i) * 2], s = p.rope[(pi * 32 + i) * 2 + 1];
        const bf16* pr = p.PROJ + (long)row * NIN; long o = (long)(row - r0) * 256 + hh * 64 + i;
        float q1 = bf2f(pr[hh * 64 + i]), q2 = bf2f(pr[hh * 64 + 32 + i]); p.sA[o] = q1 * c - q2 * s; p.sA[o + 32] = q1 * s + q2 * c;
        float k1 = bf2f(pr[256 + hh * 64 + i]), k2 = bf2f(pr[256 + hh * 64 + 32 + i]); p.sB[o] = 0.125f * (k1 * c - k2 * s); p.sB[o + 32] = 0.125f * (k1 * s + k2 * c); } };
struct FO2 { PREF p; int b, pad_;
    HD void operator()(long g) const { int e = (int)(g % 128), d = (int)((g / 128) % 64), hh = (int)((g / 8192) % 4), c = (int)(g / 32768);
        float acc = 0.f;
        for (int m = 0; m < 128; ++m) { int lr = c * 128 + m; acc += p.sB[(long)lr * 256 + hh * 64 + d] * gpow(hh, 127 - m) * bf2f(p.PROJ[(long)(b * SEQ + lr) * NIN + 512 + hh * 128 + e]); }
        p.sD[g] = acc; } };
struct FO3 { PREF p; int b, o;
    HD void operator()(long g) const { int hh = (int)(g / 8192); float S = 0.f, g128 = gpow(hh, 128);
        for (int c = 0; c < NC; ++c) { long i = (long)c * 32768 + g; p.sE[i] = S; S = g128 * S + p.sD[i]; }
        p.out[O_RP + (long)((b * 2 + o) * 4) * 8192 + g] = S; } };
struct FO4 { PREF p;
    HD void operator()(long g) const { int m = (int)(g % 128), l = (int)((g / 128) % 128), hh = (int)((g / 16384) % 4), c = (int)(g / 65536);
        float v = 0.f;
        if (m <= l) { const float* q = p.sA + (long)(c * 128 + l) * 256 + hh * 64; const float* k = p.sB + (long)(c * 128 + m) * 256 + hh * 64; float dot = 0.f; for (int d = 0; d < 64; ++d) dot += q[d] * k[d]; v = dot * gpow(hh, l - m); }
        p.sF[g] = v; } };
struct FO5 { PREF p; int b, pad_;
    HD void operator()(long g) const { int e = (int)(g % 128), l = (int)((g / 128) % 128), hh = (int)((g / 16384) % 4), c = (int)(g / 65536);
        const float* pm = p.sF + (long)(c * 4 + hh) * 16384 + l * 128; float acc = 0.f;
        for (int m = 0; m <= l; ++m) acc += pm[m] * bf2f(p.PROJ[(long)(b * SEQ + c * 128 + m) * NIN + 512 + hh * 128 + e]);
        const float* q = p.sA + (long)(c * 128 + l) * 256 + hh * 64; const float* s0 = p.sE + (long)(c * 4 + hh) * 8192 + e; float cr = 0.f; for (int d = 0; d < 64; ++d) cr += q[d] * s0[d * 128];
        p.sC[(long)(c * 128 + l) * 512 + hh * 128 + e] = acc + gpow(hh, l + 1) * cr; } };
struct FO5s { PREF p; int o, pad_;
    HD void operator()(long g) const { int e = (int)(g % 128), hh = (int)((g / 128) % 4), l = (int)((g / 512) % 4), n = (int)(g / 2048);
        const float* q = p.sA + (long)(n * 4 + l) * 256 + hh * 64; float acc = 0.f;
        for (int m = 0; m <= l; ++m) { const float* k = p.sB + (long)(n * 4 + m) * 256 + hh * 64; float dot = 0.f; for (int d = 0; d < 64; ++d) dot += q[d] * k[d];
            acc += gpow(hh, l - m) * dot * bf2f(p.PROJ[(long)(MP + n * 4 + m) * NIN + 512 + hh * 128 + e]); }
        const float* s0 = p.state_ret + (long)((n * 2 + o) * 4 + hh) * 8192 + e; float cr = 0.f; for (int d = 0; d < 64; ++d) cr += q[d] * s0[d * 128];
        p.sC[(long)(n * 4 + l) * 512 + hh * 128 + e] = acc + gpow(hh, l + 1) * cr; } };
struct FO3s { PREF p; int o, pad_;
    HD void operator()(long g) const { int e = (int)(g % 128), d = (int)((g / 128) % 64), hh = (int)((g / 8192) % 4), n = (int)(g / 32768);
        long si = (long)((n * 2 + o) * 4 + hh) * 8192 + d * 128 + e; float S = gpow(hh, 4) * p.state_ret[si];
        for (int l = 0; l < 4; ++l) S += gpow(hh, 3 - l) * p.sB[(long)(n * 4 + l) * 256 + hh * 64 + d] * bf2f(p.PROJ[(long)(MP + n * 4 + l) * NIN + 512 + hh * 128 + e]);
        p.out[O_RS + si] = S; } };
struct FO6 { PREF p; int o, r0;
    HD void operator()(long g) const { int row = r0 + (int)(g / 4), hh = (int)(g % 4); const float* ov = p.sC + (long)(row - r0) * 512 + hh * 128;
        float mu = 0.f; for (int e = 0; e < 128; ++e) mu += ov[e]; mu *= (1.0f / 128); float var = 0.f; for (int e = 0; e < 128; ++e) { float d = ov[e] - mu; var += d * d; } var *= (1.0f / 128);
        float rs = 1.0f / sqrtf(var + LN_EPS);
        for (int e = 0; e < 128; ++e) { float gt = bf2f(p.PROJ[(long)row * NIN + 1024 + hh * 128 + e]); p.Y[(long)row * DM + hh * 128 + e] = f2bf(siluf_(gt) * ((ov[e] - mu) * rs) * p.ret_gn_g[o * 512 + hh * 128 + e]); } } };
struct FO7 { PREF p; int o, r0;
    HD void operator()(long g) const { int row = r0 + (int)g; const bf16* pr = p.PROJ + (long)row * NIN + 2048; float* vd = p.sB + g * 512;
        float mu = 0.f; for (int c = 0; c < 512; ++c) { float v = geluf_(bf2f(pr[c])); vd[c] = v; mu += v; } mu *= (1.0f / 512);
        float var = 0.f; for (int c = 0; c < 512; ++c) { float d = vd[c] - mu; var += d * d; } var *= (1.0f / 512); float rs = 1.0f / sqrtf(var + LN_EPS);
        RowInfo ri = rowinfo(row);
        for (int c = 0; c < 512; ++c) { float v = (vd[c] - mu) * rs * p.gm_ln_g[o * 512 + c] + p.gm_ln_b[o * 512 + c]; vd[c] = v;
            if (ri.sample) p.out[O_CV + ((long)(ri.s * 2 + o) * 4 + ri.t) * 512 + c] = v; } } };
struct FO8 { PREF p; int o, r0;
    HD void operator()(long g) const { int row = r0 + (int)(g / 512), ch = (int)(g % 512), gg = ch >> 7; RowInfo ri = rowinfo(row);
        int tl = ri.sample ? ri.t : (ri.t & 127), cb = row - tl;
        float s = p.sp_b[(o * 4 + gg) * 128 + tl]; const float* w = p.sp_w + ((long)(o * 4 + gg) * 128 + tl) * 128;
        for (int s2 = 0; s2 <= tl; ++s2) s += w[s2] * p.sB[(long)(cb + s2 - r0) * 512 + ch];
        p.Y[(long)row * DM + 512 + ch] = f2bf(geluf_(bf2f(p.PROJ[(long)row * NIN + 1536 + ch])) * s); } };
namespace pg8 {
#define PG8_LAS __attribute__((address_space(3)))
typedef unsigned short bf16_t;
typedef short bf16x8 __attribute__((ext_vector_type(8)));
typedef float f32x4 __attribute__((ext_vector_type(4)));
typedef unsigned u32x4 __attribute__((ext_vector_type(4)));
constexpr int BM = 256, BK = 64, HALF = 128, HTB = HALF * BK * 2  , STAGE_BYTES = 8 * HTB, NXCD = 8, WGM = 8;

__host__ __device__ __forceinline__ int lds_byte(int r, int c) { const int st = (r >> 4) * 2 + (c >> 5), rr = r & 15, cc = c & 31, ob = rr * 64 + cc * 2; return st * 1024 + (ob ^ (((ob >> 9) & 1) << 5)); }
__host__ __device__ __forceinline__ void stage_rc(int b, int& R, int& C) { const int st = b / 1024, sb = b % 1024, swz = sb ^ (((sb >> 9) & 1) << 5); R = (st >> 1) * 16 + swz / 64; C = (st & 1) * 32 + (swz % 64) / 2; }
__host__ __device__ __forceinline__ int perm32(int rho) { const int n = rho >> 4, i = rho & 15; return 8 * (i >> 2) + 4 * n + (i & 3); }

struct Unit { int pm, pn; };
struct Gemm { const bf16_t* A; const bf16_t* Bt; int M, N, K; };

struct StaticOrder {
    int nM, nN, nwg, G, c;
    __host__ __device__ void init(int M, int N, int G_, int c_) { nM = M / BM; nN = N / BM; nwg = nM * nN; G = G_; c = c_; }
    __host__ __device__ bool next(int i, Unit& u) const {
        const long L = (long)i * G + c; if (L >= nwg) return false;
        int wgid = (int)L; { const int q = nwg / NXCD, r = nwg % NXCD, xcd = wgid % NXCD, off = wgid / NXCD; wgid = (xcd < r ? xcd * (q + 1) : r * (q + 1) + (xcd - r) * q) + off; }
        const int nig = WGM * nN, gid = wgid / nig, fm = gid * WGM, gsz = (nM - fm) < WGM ? (nM - fm) : WGM;
        u.pm = fm + ((wgid % nig) % gsz); u.pn = (wgid % nig) / gsz; return true;
    }
    __device__ __forceinline__ void a_ready(const Unit&) const {}
    __device__ __forceinline__ void done(const Unit&) const {}
};

__device__ __forceinline__ unsigned cvt_pk_bf16(float lo, float hi) { unsigned r; asm volatile("v_cvt_pk_bf16_f32 %0, %1, %2" : "=v"(r) : "v"(lo), "v"(hi)); return r; }
struct EpiProj {
    static constexpr bool PERM = true, AFTER_DRAIN = false;
    bf16_t* O; int ldc;
    __device__ __forceinline__ void operator()(const f32x4 (&acc)[2][2][4][2], const Unit& u, int wr, int wc, int fr, int fq) const {
        const int row0 = u.pm * BM + wr * 64 + fr, col0 = u.pn * BM + wc * 32 + 8 * fq;
#pragma unroll
        for (int ai = 0; ai < 2; ++ai)
#pragma unroll
            for (int m = 0; m < 4; ++m) { bf16_t* rowp = O + (size_t)(row0 + ai * HALF + m * 16) * ldc + col0;
#pragma unroll
                for (int bj = 0; bj < 2; ++bj) { const f32x4 v0 = acc[ai][bj][m][0], v1 = acc[ai][bj][m][1];
                    u32x4 w; w.x = cvt_pk_bf16(v0[0], v0[1]); w.y = cvt_pk_bf16(v0[2], v0[3]); w.z = cvt_pk_bf16(v1[0], v1[1]); w.w = cvt_pk_bf16(v1[2], v1[3]);
                    *(u32x4*)(rowp + bj * HALF) = w; } }
    }
};
__device__ __forceinline__ float silu_f(float x) { return x / (1.0f + __expf(-x)); }
struct EpiSwiglu {
    static constexpr bool PERM = true, AFTER_DRAIN = false;
    bf16_t* O; int ldc;
    __device__ __forceinline__ void operator()(const f32x4 (&acc)[2][2][4][2], const Unit& u, int wr, int wc, int fr, int fq) const {
        const int row0 = u.pm * BM + wr * 64 + fr, col0 = u.pn * HALF + wc * 32 + 8 * fq;
#pragma unroll
        for (int ai = 0; ai < 2; ++ai)
#pragma unroll
            for (int m = 0; m < 4; ++m) { bf16_t* rowp = O + (size_t)(row0 + ai * HALF + m * 16) * ldc + col0;
                float h[8];
#pragma unroll
                for (int n = 0; n < 2; ++n)
#pragma unroll
                    for (int i = 0; i < 4; ++i) h[n * 4 + i] = silu_f(acc[ai][0][m][n][i]) * acc[ai][1][m][n][i];
                u32x4 w; w.x = cvt_pk_bf16(h[0], h[1]); w.y = cvt_pk_bf16(h[2], h[3]); w.z = cvt_pk_bf16(h[4], h[5]); w.w = cvt_pk_bf16(h[6], h[7]);
                *(u32x4*)rowp = w; }
    }
};
struct EpiRes {
    static constexpr bool PERM = false, AFTER_DRAIN = false;
    float* X; int ldc; float alpha;
    __device__ __forceinline__ void operator()(const f32x4 (&acc)[2][2][4][2], const Unit& u, int wr, int wc, int fr, int fq) const {
        const int row0 = u.pm * BM + wr * 64 + fr, col0 = u.pn * BM + wc * 32 + 4 * fq;
#pragma unroll
        for (int ai = 0; ai < 2; ++ai)
#pragma unroll
            for (int m = 0; m < 4; ++m) { float* rowp = X + (size_t)(row0 + ai * HALF + m * 16) * ldc + col0;
#pragma unroll
                for (int bj = 0; bj < 2; ++bj)
#pragma unroll
                    for (int n = 0; n < 2; ++n) { f32x4* q = (f32x4*)(rowp + bj * HALF + n * 16); *q = *q * alpha + acc[ai][bj][m][n]; } }
    }
};
template <class Epi, class Sched, bool ALIGN_EPI = false, bool SP2 = false>
__device__ __forceinline__ void gemm_phase(PG8_LAS unsigned char* lds, const Gemm g, const Sched& S, const Epi& E) {
    int tid_ = threadIdx.x; asm volatile("" : "+v"(tid_)); const int tid = tid_, wid = __builtin_amdgcn_readfirstlane(tid >> 6), lane = tid & 63, wr = wid >> 2, wc = wid & 3, fr = lane & 15, fq = lane >> 4;
    const int K = g.K, nt = K / BK;
    unsigned voffA[2], voffB[2];
#pragma unroll
    for (int i = 0; i < 2; ++i) { int R, C; stage_rc(tid * 16 + i * 8192, R, C); const int Rb = Epi::PERM ? ((R & ~31) + perm32(R & 31)) : R;
        voffA[i] = (unsigned)(R * K + C) * 2u; voffB[i] = (unsigned)(Rb * K + C) * 2u; }
    const size_t kstep = (size_t)(BK * 2);
    const size_t hstep = (size_t)HALF * K * 2;
    const size_t tstep = 2 * hstep;
    const unsigned ldsw = (unsigned)wid * 1024u;
    const int aoff = lds_byte(wr * 64 + fr, fq * 8), boff = lds_byte(wc * 32 + fr, fq * 8);
#define PG8_SA(b, h) (((b) * 2 + (h)) * HTB)
#define PG8_SB(b, h) ((4 + (b) * 2 + (h)) * HTB)
#define PG8_STAGE(bufoff, gbase, voff) do { _Pragma("unroll") for (int _i = 0; _i < 2; ++_i) \
        __builtin_amdgcn_global_load_lds((const unsigned*)((const char*)(gbase) + (voff)[_i]), (PG8_LAS unsigned*)(lds + (bufoff) + ldsw + _i * 8192), 16, 0, 0); } while (0)
#define PG8_LDA(dst, b, h) do { _Pragma("unroll") for (int m = 0; m < 4; ++m) _Pragma("unroll") for (int k = 0; k < 2; ++k) dst[m][k] = *(const PG8_LAS bf16x8*)(lds + PG8_SA(b, h) + aoff + m * 2048 + k * 1024); } while (0)
#define PG8_LDB(dst, b, h) do { _Pragma("unroll") for (int n = 0; n < 2; ++n) _Pragma("unroll") for (int k = 0; k < 2; ++k) dst[n][k] = *(const PG8_LAS bf16x8*)(lds + PG8_SB(b, h) + boff + n * 2048 + k * 1024); } while (0)
#define PG8_MMA(ai, bj, At, Bt) do { __builtin_amdgcn_s_setprio(1); _Pragma("unroll") for (int m = 0; m < 4; ++m) _Pragma("unroll") for (int n = 0; n < 2; ++n) _Pragma("unroll") for (int k = 0; k < 2; ++k) \
        acc[ai][bj][m][n] = __builtin_amdgcn_mfma_f32_16x16x32_bf16(Bt[n][k], At[m][k], acc[ai][bj][m][n], 0, 0, 0); __builtin_amdgcn_s_setprio(0); } while (0)
#define PG8_WAIT_V(n) asm volatile("s_waitcnt vmcnt(" #n ")" ::: "memory")
#define PG8_WAIT_L(n) asm volatile("s_waitcnt lgkmcnt(" #n ")" ::: "memory")
#define PG8_BAR __builtin_amdgcn_s_barrier()
#define PG8_SCHED __builtin_amdgcn_sched_barrier(0)
    Unit cur, nxt; int ui = 0;
    if (!S.next(0, cur)) return;
    f32x4 acc[2][2][4][2];
#pragma unroll
    for (int a = 0; a < 2; ++a)
#pragma unroll
        for (int b = 0; b < 2; ++b)
#pragma unroll
            for (int m = 0; m < 4; ++m)
#pragma unroll
                for (int n = 0; n < 2; ++n) acc[a][b][m][n] = (f32x4){0.f, 0.f, 0.f, 0.f};
    bf16x8 At[4][2], B0[2][2], B1[2][2];
    const char* cA = (const char*)g.A + (size_t)cur.pm * tstep; const char* cB = (const char*)g.Bt + (size_t)cur.pn * tstep;
    S.a_ready(cur);
    if constexpr (SP2) {
        PG8_STAGE(PG8_SB(0, 0), cB, voffB); PG8_STAGE(PG8_SB(0, 1), cB + hstep, voffB); PG8_STAGE(PG8_SA(0, 0), cA, voffA); PG8_STAGE(PG8_SA(0, 1), cA + hstep, voffA);
        if (wr == 1) PG8_BAR;
        PG8_WAIT_V(2); PG8_BAR;
        PG8_STAGE(PG8_SB(1, 0), cB + kstep, voffB); PG8_STAGE(PG8_SA(1, 0), cA + kstep, voffA); PG8_STAGE(PG8_SB(1, 1), cB + hstep + kstep, voffB);
        PG8_WAIT_V(6); PG8_BAR;
    } else {
        PG8_STAGE(PG8_SB(0, 0), cB, voffB); PG8_STAGE(PG8_SA(0, 0), cA, voffA); PG8_STAGE(PG8_SB(0, 1), cB + hstep, voffB); PG8_STAGE(PG8_SA(0, 1), cA + hstep, voffA);
        if (wr == 1) PG8_BAR;
        PG8_WAIT_V(4); PG8_BAR;
        PG8_STAGE(PG8_SB(1, 0), cB + kstep, voffB); PG8_STAGE(PG8_SA(1, 0), cA + kstep, voffA); PG8_STAGE(PG8_SB(1, 1), cB + hstep + kstep, voffB);
        PG8_WAIT_V(6); PG8_BAR;
    }
    for (;;) {
        const bool has_next = S.next(ui + 1, nxt);
        const char* nA = has_next ? (const char*)g.A + (size_t)nxt.pm * tstep : cA; const char* nB = has_next ? (const char*)g.Bt + (size_t)nxt.pn * tstep : cB;
        for (int t = 0; t < nt; t += 2) {
            const bool last = (t == nt - 2);
            const char* a1 = cA + (size_t)(t + 1) * kstep;
            const char* a2 = last ? nA : cA + (size_t)(t + 2) * kstep; const char* b2 = last ? nB : cB + (size_t)(t + 2) * kstep;
            const char* a3 = a2 + kstep; const char* b3 = b2 + kstep;
            if (last && has_next) S.a_ready(nxt);
            if constexpr (SP2) {
            PG8_LDB(B0, 0, 0); PG8_LDB(B1, 0, 1); PG8_SCHED; PG8_LDA(At, 0, 0); PG8_STAGE(PG8_SA(1, 1), a1 + hstep, voffA);
            PG8_WAIT_V(8); PG8_WAIT_L(0); PG8_BAR; PG8_MMA(0, 0, At, B0); PG8_MMA(0, 1, At, B1); PG8_BAR; PG8_SCHED;
            PG8_LDA(At, 0, 1); PG8_STAGE(PG8_SB(0, 0), b2, voffB); PG8_STAGE(PG8_SB(0, 1), b2 + hstep, voffB); PG8_STAGE(PG8_SA(0, 0), a2, voffA);
            PG8_WAIT_V(8); PG8_WAIT_L(0); PG8_BAR; PG8_MMA(1, 0, At, B0); PG8_MMA(1, 1, At, B1); PG8_BAR; PG8_SCHED;
            PG8_LDB(B0, 1, 0); PG8_LDB(B1, 1, 1); PG8_SCHED; PG8_LDA(At, 1, 0); PG8_STAGE(PG8_SA(0, 1), a2 + hstep, voffA);
            PG8_WAIT_V(8); PG8_WAIT_L(0); PG8_BAR; PG8_MMA(0, 0, At, B0); PG8_MMA(0, 1, At, B1); PG8_BAR; PG8_SCHED;
            PG8_LDA(At, 1, 1); PG8_STAGE(PG8_SB(1, 0), b3, voffB); PG8_STAGE(PG8_SB(1, 1), b3 + hstep, voffB); PG8_STAGE(PG8_SA(1, 0), a3, voffA);
            PG8_WAIT_V(8); PG8_WAIT_L(0); PG8_BAR; PG8_MMA(1, 0, At, B0); PG8_MMA(1, 1, At, B1); PG8_BAR; PG8_SCHED;
            } else {
            PG8_LDB(B0, 0, 0); PG8_SCHED; PG8_LDA(At, 0, 0); PG8_STAGE(PG8_SA(1, 1), a1 + hstep, voffA);
            PG8_WAIT_L(8); PG8_BAR; PG8_WAIT_L(0); PG8_MMA(0, 0, At, B0); PG8_BAR; PG8_SCHED;
            PG8_LDB(B1, 0, 1); PG8_STAGE(PG8_SB(0, 0), b2, voffB);
            PG8_BAR; PG8_WAIT_L(0); PG8_MMA(0, 1, At, B1); PG8_BAR;
            PG8_LDA(At, 0, 1); PG8_STAGE(PG8_SA(0, 0), a2, voffA);
            PG8_BAR; PG8_WAIT_L(0); PG8_MMA(1, 0, At, B0); PG8_BAR; PG8_SCHED;
            PG8_STAGE(PG8_SB(0, 1), b2 + hstep, voffB);
            PG8_WAIT_V(6); PG8_BAR; PG8_MMA(1, 1, At, B1); PG8_BAR;
            PG8_LDB(B0, 1, 0); PG8_SCHED; PG8_LDA(At, 1, 0); PG8_STAGE(PG8_SA(0, 1), a2 + hstep, voffA);
            PG8_WAIT_L(8); PG8_BAR; PG8_WAIT_L(0); PG8_MMA(0, 0, At, B0); PG8_BAR; PG8_SCHED;
            PG8_LDB(B1, 1, 1); PG8_STAGE(PG8_SB(1, 0), b3, voffB);
            PG8_BAR; PG8_WAIT_L(0); PG8_MMA(0, 1, At, B1); PG8_BAR;
            PG8_LDA(At, 1, 1); PG8_STAGE(PG8_SA(1, 0), a3, voffA);
            PG8_BAR; PG8_WAIT_L(0); PG8_MMA(1, 0, At, B0); PG8_BAR; PG8_SCHED;
            PG8_STAGE(PG8_SB(1, 1), b3 + hstep, voffB);
            PG8_WAIT_V(6); PG8_BAR; PG8_MMA(1, 1, At, B1); PG8_BAR;
            }
        }
        if constexpr (ALIGN_EPI) { if (wr == 0) PG8_BAR; }
        if constexpr (!Epi::AFTER_DRAIN) { E(acc, cur, wr, wc, fr, fq); S.done(cur); }
        if (!has_next) break;
#pragma unroll
        for (int a = 0; a < 2; ++a)
#pragma unroll
            for (int b = 0; b < 2; ++b)
#pragma unroll
                for (int m = 0; m < 4; ++m)
#pragma unroll
                    for (int n = 0; n < 2; ++n) acc[a][b][m][n] = (f32x4){0.f, 0.f, 0.f, 0.f};
        cur = nxt; cA = nA; cB = nB; ++ui;
        if constexpr (ALIGN_EPI) { if (wr == 1) PG8_BAR; }
    }
    PG8_WAIT_V(0);
    if constexpr (!ALIGN_EPI) { if (wr == 0) PG8_BAR; }
    PG8_BAR;
    if constexpr (Epi::AFTER_DRAIN) { E.fused(acc, cur, wr, wc, fr, fq, lds, wid, lane); S.done(cur); }
#undef PG8_SA
#undef PG8_SB
#undef PG8_STAGE
#undef PG8_LDA
#undef PG8_LDB
#undef PG8_MMA
#undef PG8_WAIT_V
#undef PG8_WAIT_L
#undef PG8_BAR
#undef PG8_SCHED
}
}
#include <hip/hip_cooperative_groups.h>
namespace cg = cooperative_groups;
#define LAS __attribute__((address_space(3)))
typedef float f32x4 __attribute__((ext_vector_type(4)));
typedef unsigned u32x2 __attribute__((ext_vector_type(2)));
typedef unsigned u32x4 __attribute__((ext_vector_type(4)));
typedef short bf16x8 __attribute__((ext_vector_type(8)));
constexpr int NTHR = 512, NWAVES = 8, LDS_BYTES = 147456;
#define LDS_WAIT() asm volatile("s_waitcnt lgkmcnt(0)" ::: "memory")
__device__ __forceinline__ unsigned pk2(float lo, float hi) { return pg8::cvt_pk_bf16(lo, hi); }
__device__ __forceinline__ float wave_sum(float v) {
#pragma unroll
    for (int o = 1; o < 64; o <<= 1) v += __shfl_xor(v, o);
    return v;
}
struct Ctx { LAS unsigned char* lds; int tid, lane, wave, gw, ngw; };
__device__ __forceinline__ Ctx mkctx(LAS unsigned char* lds) { Ctx c; c.lds = lds; int t = threadIdx.x; asm volatile("" : "+v"(t)); c.tid = t; c.lane = t & 63; c.wave = __builtin_amdgcn_readfirstlane(t >> 6);
    c.gw = (int)blockIdx.x * NWAVES + c.wave; c.ngw = (int)gridDim.x * NWAVES; return c; }
__device__ __forceinline__ PREF kparams() { const CONSTAS P* q = (const CONSTAS P*)__builtin_amdgcn_kernarg_segment_ptr(); asm volatile("" : "+s"(q)); return *q; }
constexpr int MISC_OFF = 131072;
#define XB_TMO      128
#define XB_XCNT(j)  (256  + 64 * (j))
#define XB_XSUB(j)  (1280 + 64 * (j))
#define XB_XGEN(j)  (2304 + 64 * (j))
#define XB_TOP      3328
#define XB_TOPGEN   3392
#define XCD_BAR_WORDS 3456
#define XB_SPIN_CAP (1u << 18)

__device__ __forceinline__ unsigned xb_ld(unsigned* p)              { return __hip_atomic_load(p, __ATOMIC_RELAXED, __HIP_MEMORY_SCOPE_AGENT); }
__device__ __forceinline__ unsigned xb_add(unsigned* p, unsigned v) { return __hip_atomic_fetch_add(p, v, __ATOMIC_RELAXED, __HIP_MEMORY_SCOPE_AGENT); }
__device__ __forceinline__ unsigned xb_xcc_id() { return (unsigned)__builtin_amdgcn_s_getreg((3 << 11) | 20) & 0xFu; }
#define XB_SPIN(cond, bar) do { unsigned _sp = 0; while (cond) { __builtin_amdgcn_s_sleep(1); \
    if ((++_sp & 255u) == 0u) { if (xb_ld(&(bar)[XB_TMO])) break; if (_sp > XB_SPIN_CAP) { atomicAdd(&(bar)[XB_TMO], 1u); break; } } } } while (0)

struct XcdBarrier {
    unsigned* bar; unsigned x;
    volatile LAS unsigned* st;
};

__device__ __forceinline__ XcdBarrier xcd_barrier_post(unsigned* bar, volatile LAS unsigned* st) {
    XcdBarrier b; b.bar = bar; b.x = xb_xcc_id(); b.st = st;
    if (threadIdx.x == 0) (void)xb_add(&bar[XB_XCNT(b.x)], 1u);
    return b;
}
__device__ __forceinline__ void xcd_barrier_complete(unsigned* bar, unsigned x, unsigned& nloc, unsigned& nx) {
    const unsigned G = gridDim.x * gridDim.y * gridDim.z;
    unsigned sum, cnt, mine, sp = 0u;
    for (;;) {
        sum = 0u; cnt = 0u; mine = 0u;
#pragma unroll
        for (unsigned j = 0; j < 16; ++j) { const unsigned c = xb_ld(&bar[XB_XCNT(j)]); sum += c; cnt += (c > 0u) ? 1u : 0u; mine = (j == x) ? c : mine; }
        if (sum == G) break;
        __builtin_amdgcn_s_sleep(1);
        if ((++sp & 255u) == 0u) { if (xb_ld(&bar[XB_TMO])) break; if (sp > XB_SPIN_CAP) { atomicAdd(&bar[XB_TMO], 1u); break; } }
    }
    nloc = mine > 0u ? mine : 1u; nx = cnt > 0u ? cnt : 1u;
}

__device__ __forceinline__ void xcd_barrier(const XcdBarrier& b) {
    asm volatile("s_waitcnt vmcnt(0)" ::: "memory");
    __syncthreads();
    if (threadIdx.x == 0) {
        unsigned* bar = b.bar;
        __builtin_amdgcn_s_waitcnt(0);
        unsigned nloc = b.st[0], nx = b.st[1];
        if (nloc == 0u) { xcd_barrier_complete(bar, b.x, nloc, nx); b.st[0] = nloc; b.st[1] = nx; }
        const unsigned old = xb_add(&bar[XB_XSUB(b.x)], 1u);
        const unsigned gen = old / nloc;
        if (old + 1u == (gen + 1u) * nloc) {
            __builtin_amdgcn_fence(__ATOMIC_RELEASE, "agent");
            asm volatile("s_waitcnt vmcnt(0)" ::: "memory");
            const unsigned og = xb_add(&bar[XB_TOP], 1u);
            const unsigned tg = og / nx;
            if (og + 1u == (tg + 1u) * nx) xb_add(&bar[XB_TOPGEN], 1u);
            else XB_SPIN(xb_ld(&bar[XB_TOPGEN]) == tg, bar);
            __builtin_amdgcn_fence(__ATOMIC_ACQUIRE, "agent");
            xb_add(&bar[XB_XGEN(b.x)], 1u);
            asm volatile("s_waitcnt vmcnt(0)" ::: "memory");
        } else {
            XB_SPIN(xb_ld(&bar[XB_XGEN(b.x)]) == gen, bar);
            __builtin_amdgcn_fence(__ATOMIC_ACQUIRE, "agent");
            asm volatile("s_waitcnt vmcnt(0)" ::: "memory");
        }
    }
    __syncthreads();
}
__device__ __forceinline__ void grid_barrier(LAS unsigned char* lds) {
    XcdBarrier b; b.bar = (unsigned*)(kparams().ws + WS_CTL); b.x = xb_xcc_id(); b.st = (volatile LAS unsigned*)(lds + MISC_OFF) + 8;
    xcd_barrier(b);
}
#define GRID_SYNC() grid_barrier(lds)

template <class F> __device__ __forceinline__ void run_simple(F f, long n) {
    int tid = threadIdx.x; asm volatile("" : "+v"(tid));
    for (long g = (long)blockIdx.x * NTHR + tid; g < n; g += (long)gridDim.x * NTHR) f(g);
}

__device__ __forceinline__ void transpose_item(const float* W, int N, bf16* WT, int Kd, int k0, int n0, int drow0, LAS float* scr, int lane) {
#pragma unroll 8
    for (int i = 0; i < 32; ++i) { const int kk = 2 * i + (lane >> 5); scr[kk * 33 + (lane & 31)] = W[(size_t)(k0 + kk) * N + n0 + (lane & 31)]; }
    LDS_WAIT();
    const int c = lane & 7;
#pragma unroll
    for (int j = 0; j < 4; ++j) { const int n = (lane >> 3) + 8 * j; const LAS float* s = scr + (8 * c) * 33 + n;
        u32x4 o; o.x = pk2(s[0 * 33], s[1 * 33]); o.y = pk2(s[2 * 33], s[3 * 33]); o.z = pk2(s[4 * 33], s[5 * 33]); o.w = pk2(s[6 * 33], s[7 * 33]);
        *(u32x4*)(WT + (size_t)(drow0 + n) * Kd + k0 + 8 * c) = o; }
    LDS_WAIT();
}
__device__ __forceinline__ void phase_prep(const Ctx& c) {
    PREF p = kparams();
    LAS float* scr = (LAS float*)(c.lds + c.wave * 16384);
    constexpr int I_IN = (DM / 64) * (NIN / 32), I_OUT = (DM / 64) * (DM / 32), I_F = (DM / 64) * (DFF / 32), I_2 = (DFF / 64) * (DM / 32), I_L = I_IN + I_OUT + 2 * I_F + I_2;
    for (int it = c.gw; it < DEPTH * I_L; it += c.ngw) {
        const int l = it / I_L; int r = it % I_L;
        if (r < I_IN) { const float* W = (l % 2 == 0 ? p.w_in_even : p.w_in_odd) + (size_t)(l / 2) * DM * NIN; const int nb = NIN / 32;
            transpose_item(W, NIN, p.Wt_in + (size_t)l * NIN * DM, DM, 64 * (r / nb), 32 * (r % nb), 32 * (r % nb), scr, c.lane); continue; } r -= I_IN;
        if (r < I_OUT) { const float* W = (l % 2 == 0 ? p.w_out_even : p.w_out_odd) + (size_t)(l / 2) * DM * DM; const int nb = DM / 32;
            transpose_item(W, DM, p.Wt_out + (size_t)l * DM * DM, DM, 64 * (r / nb), 32 * (r % nb), 32 * (r % nb), scr, c.lane); continue; } r -= I_OUT;
        if (r < 2 * I_F) { const int half = r >= I_F; if (half) r -= I_F; const float* W = (half ? p.ffn_w3 : p.ffn_w1) + (size_t)l * DM * DFF; const int nb = DFF / 32, n0 = 32 * (r % nb);
            transpose_item(W, DFF, p.Wt_13 + (size_t)l * 2 * DFF * DM, DM, 64 * (r / nb), n0, (n0 >> 7) * 256 + half * 128 + (n0 & 127), scr, c.lane); continue; } r -= 2 * I_F;
        { const float* W = p.ffn_w2 + (size_t)l * DFF * DM; const int nb = DM / 32;
            transpose_item(W, DM, p.Wt_2 + (size_t)l * DM * DFF, DFF, 64 * (r / nb), 32 * (r % nb), 32 * (r % nb), scr, c.lane); }
    }
    for (long i = (long)blockIdx.x * NTHR + c.tid; i < (long)M * DM / 4; i += (long)gridDim.x * NTHR) {
        const f32x4 v = i < (long)MP * DM / 4 ? ((const f32x4*)p.x_prompt)[i] : ((const f32x4*)p.x_sample)[i - (long)MP * DM / 4];
        ((f32x4*)p.XF)[i] = v; u32x2 w; w.x = pk2(v.x, v.y); w.y = pk2(v.z, v.w); ((u32x2*)p.XB)[i] = w; }
    run_simple(FRope{p.rope}, (long)(SEQ + 4) * 32);
    for (int i = (int)blockIdx.x * NTHR + c.tid; i < 2 * 8 * 64 * 64; i += (int)gridDim.x * NTHR) { const int eg = i >> 12, j = (i >> 6) & 63, ii = i & 63;
        p.WaT[i] = f2bf(p.lru_wa[eg * 4096 + ii * 64 + j]); p.WxT[i] = f2bf(p.lru_wx[eg * 4096 + ii * 64 + j]); }
    for (int i = (int)blockIdx.x * NTHR + c.tid; i < 2 * 4 * 128 * 128; i += (int)gridDim.x * NTHR) { const int t = (i >> 7) & 127, s2 = i & 127; p.Wtril[i] = s2 <= t ? f2bf(p.sp_w[i]) : (bf16)0; }
}

__device__ __forceinline__ void phase_ln(const Ctx& c, const float* g, const float* b) {
    PREF p = kparams();
    f32x4 gv[4], bv[4];
#pragma unroll
    for (int j = 0; j < 4; ++j) { gv[j] = ((const f32x4*)g)[c.lane + 64 * j]; bv[j] = ((const f32x4*)b)[c.lane + 64 * j]; }
    for (int row = c.gw; row < M; row += c.ngw) {
        f32x4* xr = (f32x4*)(p.XF + (size_t)row * DM) + c.lane; f32x4 v[4]; float s = 0.f;
#pragma unroll
        for (int j = 0; j < 4; ++j) { v[j] = xr[64 * j]; s += (v[j].x + v[j].y) + (v[j].z + v[j].w); }
        const float mean = wave_sum(s) * (1.f / DM); float s2 = 0.f;
#pragma unroll
        for (int j = 0; j < 4; ++j) { v[j] = v[j] - mean; s2 += (v[j].x * v[j].x + v[j].y * v[j].y) + (v[j].z * v[j].z + v[j].w * v[j].w); }
        const float rstd = 1.f / sqrtf(wave_sum(s2) * (1.f / DM) + LN_EPS);
        u32x2* o8 = (u32x2*)(p.XB + (size_t)row * DM) + c.lane;
#pragma unroll
        for (int j = 0; j < 4; ++j) { const f32x4 o = v[j] * rstd * gv[j] + bv[j]; xr[64 * j] = o; u32x2 w; w.x = pk2(o.x, o.y); w.y = pk2(o.z, o.w); o8[64 * j] = w; }
    }
}

template <class Epi> __device__ __forceinline__ void phase_gemm(const Ctx& c, const bf16* A, const bf16* Bt, int Mrows, int N, int K, Epi E) {
    pg8::Gemm g{A, Bt, Mrows, N, K}; pg8::StaticOrder S; S.init(Mrows, N, (int)gridDim.x, (int)blockIdx.x);
    pg8::gemm_phase<Epi, pg8::StaticOrder, true, true>(c.lds, g, S, E);
}

__device__ __forceinline__ void sample_gemm_tail(const Ctx& c, const bf16* A, const bf16* Bt, int K, float* X, float alpha) {
    constexpr int NU = (MS / 32) * (DM / 64);
    const int lane = c.lane, q = lane >> 4, r16 = lane & 15, w = c.wave;
    for (int u = (int)blockIdx.x; u < NU; u += (int)gridDim.x) {
        const int um = u / (DM / 64), un = u % (DM / 64), kw = K / 8, nks = kw / 32, ng = (nks + 2) / 3;
        const bf16* ap = A + (size_t)(MP + 32 * um + r16) * K + w * kw + 8 * q; const bf16* bp = Bt + (size_t)(64 * un + r16) * K + w * kw + 8 * q;
        f32x4 acc[2][4];
#pragma unroll
        for (int i = 0; i < 2; ++i)
#pragma unroll
            for (int j = 0; j < 4; ++j) acc[i][j] = (f32x4){0.f, 0.f, 0.f, 0.f};
        bf16x8 fa0[3][2], fb0[3][4], fa1[3][2], fb1[3][4];
#define SG_LOAD(fa, fb, g) do { _Pragma("unroll") for (int s = 0; s < 3; ++s) if ((g) * 3 + s < nks) { \
            _Pragma("unroll") for (int i = 0; i < 2; ++i) fa[s][i] = *(const bf16x8*)(ap + (size_t)(16 * i) * K + ((g) * 3 + s) * 32); \
            _Pragma("unroll") for (int j = 0; j < 4; ++j) fb[s][j] = *(const bf16x8*)(bp + (size_t)(16 * j) * K + ((g) * 3 + s) * 32); } } while (0)
#define SG_MMA(fa, fb, g) do { _Pragma("unroll") for (int s = 0; s < 3; ++s) if ((g) * 3 + s < nks) { \
            _Pragma("unroll") for (int i = 0; i < 2; ++i) _Pragma("unroll") for (int j = 0; j < 4; ++j) acc[i][j] = __builtin_amdgcn_mfma_f32_16x16x32_bf16(fb[s][j], fa[s][i], acc[i][j], 0, 0, 0); } } while (0)
        SG_LOAD(fa0, fb0, 0);
        for (int g = 0; g < ng; g += 2) {
            if (g + 1 < ng) SG_LOAD(fa1, fb1, g + 1);
            SG_MMA(fa0, fb0, g);
            if (g + 2 < ng) SG_LOAD(fa0, fb0, g + 2);
            if (g + 1 < ng) SG_MMA(fa1, fb1, g + 1);
        }
#undef SG_LOAD
#undef SG_MMA
        LAS float* Pw = (LAS float*)c.lds + w * 2048;
#pragma unroll
        for (int i = 0; i < 2; ++i)
#pragma unroll
            for (int j = 0; j < 4; ++j) *(LAS f32x4*)(Pw + (16 * i + r16) * 64 + 16 * j + 4 * q) = acc[i][j];
        __syncthreads();
        { const int m = c.tid >> 4, n4 = (c.tid & 15) * 4; f32x4 s0 = {0.f, 0.f, 0.f, 0.f};
#pragma unroll
          for (int ww = 0; ww < 8; ++ww) s0 += *(const LAS f32x4*)((LAS float*)c.lds + ww * 2048 + m * 64 + n4);
          f32x4* xp = (f32x4*)(X + (size_t)(MP + 32 * um + m) * DM + 64 * un + n4); xp[0] = xp[0] * alpha + s0; }
        __syncthreads();
    }
}

#define FAST_EVEN 1
#define FAST_ODD 1
constexpr int LCH = 64, NCH = SEQ / LCH;
constexpr int N_PU = BATCH * NCH * 8, N_SU = (MS / LCH) * 8;
constexpr int LRU_LDS_WAVE = 11264;
__device__ __forceinline__ float gelu_fast(float x) { const float u = 0.7978845608028654f * (x + 0.044715f * x * x * x); return x / (1.0f + __expf(-2.0f * u)); }
__device__ __forceinline__ float silu_fast(float x) { return x / (1.0f + __expf(-x)); }
__device__ __forceinline__ float sigmoid_fast(float x) { return 1.0f / (1.0f + __expf(-x)); }
template <int MODE> __device__ __forceinline__ void lru_unit(const Ctx& c, PREF p, int e, int sample, int row0, int b, int ch64, int g) {
    const int lane = c.lane, ch = g * 64 + lane, q = lane >> 4, r16 = lane & 15;
    LAS unsigned char* wl = c.lds + c.wave * LRU_LDS_WAVE;
    LAS bf16* XT = (LAS bf16*)wl; LAS float* GR = (LAS float*)(wl + 2304); LAS float* GI = (LAS float*)(wl + 2304 + 4352);
    const float cw0 = p.conv_a_w[(e * 4 + 0) * 512 + ch], cw1 = p.conv_a_w[(e * 4 + 1) * 512 + ch], cw2 = p.conv_a_w[(e * 4 + 2) * 512 + ch], cw3 = p.conv_a_w[(e * 4 + 3) * 512 + ch];
    const float cb = p.conv_a_b[e * 512 + ch], ba = p.lru_ba[e * 512 + ch], bx = p.lru_bx[e * 512 + ch], sp8 = -8.0f * log1pf(expf(-p.lru_lam[e * 512 + ch]));
    float wb0 = 0.f, wb1 = 0.f, wb2 = 0.f;
    if (MODE == 1) { wb0 = p.conv_b_w[(e * 3 + 0) * 512 + ch]; wb1 = p.conv_b_w[(e * 3 + 1) * 512 + ch]; wb2 = p.conv_b_w[(e * 3 + 2) * 512 + ch]; }
    bf16x8 wa_f[4][2], wx_f[4][2];
    { const bf16* wa = p.WaT + (size_t)((e * 8 + g) * 64) * 64; const bf16* wx = p.WxT + (size_t)((e * 8 + g) * 64) * 64;
#pragma unroll
      for (int nt = 0; nt < 4; ++nt)
#pragma unroll
        for (int ks = 0; ks < 2; ++ks) { wa_f[nt][ks] = *(const bf16x8*)(wa + (16 * nt + r16) * 64 + ks * 32 + 8 * q); wx_f[nt][ks] = *(const bf16x8*)(wx + (16 * nt + r16) * 64 + ks * 32 + 8 * q); } }
    float h = 0.f, aprod = 1.f, x1 = 0.f, x2 = 0.f, x3 = 0.f, c1 = 0.f, c2 = 0.f;
    const bf16* pr0 = p.PROJ + (size_t)row0 * NIN + ch;
    if (!sample) {
        if (ch64 > 0) { x1 = bf2f(pr0[-1 * NIN]); x2 = bf2f(pr0[-2 * NIN]); x3 = bf2f(pr0[-3 * NIN]);
            if (MODE == 1) { c1 = bf2f(pr0[-1 * NIN + 1536]) * bf2f(pr0[-1 * NIN + 2048]); c2 = bf2f(pr0[-2 * NIN + 1536]) * bf2f(pr0[-2 * NIN + 2048]);
                const float* ap = p.AP + (size_t)b * NCH * 512 + ch; const float* he = p.HE + (size_t)b * NCH * 512 + ch;
                for (int j = 0; j < ch64; ++j) h = ap[j * 512] * h + he[j * 512]; } }
    }
    for (int sb = 0; sb < LCH / 16; ++sb) {
        const int rb = row0 + 16 * sb; const bf16* pr = p.PROJ + (size_t)rb * NIN + ch;
        float xa[16], xc[16];
#pragma unroll
        for (int t = 0; t < 16; ++t) xa[t] = bf2f(pr[t * NIN]);
#pragma unroll
        for (int t = 0; t < 16; ++t) {
            if (sample && (t & 3) == 0) { const float* st = p.state_lru_conv + (size_t)((((rb + t - MP) >> 2) * 2 + e) * 3) * 512 + ch; x3 = st[0]; x2 = st[512]; x1 = st[1024]; }
            xc[t] = cb + cw0 * x3 + cw1 * x2 + cw2 * x1 + cw3 * xa[t]; x3 = x2; x2 = x1; x1 = xa[t];
            XT[t * 72 + lane] = f2bf(xc[t]);
        }
        LDS_WAIT();
        { bf16x8 y0 = *(const LAS bf16x8*)(XT + r16 * 72 + 8 * q), y1 = *(const LAS bf16x8*)(XT + r16 * 72 + 32 + 8 * q);
#pragma unroll
          for (int nt = 0; nt < 4; ++nt) { f32x4 ar = {0.f, 0.f, 0.f, 0.f}, ai = {0.f, 0.f, 0.f, 0.f};
              ar = __builtin_amdgcn_mfma_f32_16x16x32_bf16(wa_f[nt][0], y0, ar, 0, 0, 0); ar = __builtin_amdgcn_mfma_f32_16x16x32_bf16(wa_f[nt][1], y1, ar, 0, 0, 0);
              ai = __builtin_amdgcn_mfma_f32_16x16x32_bf16(wx_f[nt][0], y0, ai, 0, 0, 0); ai = __builtin_amdgcn_mfma_f32_16x16x32_bf16(wx_f[nt][1], y1, ai, 0, 0, 0);
              *(LAS f32x4*)(GR + r16 * 68 + 16 * nt + 4 * q) = ar; *(LAS f32x4*)(GI + r16 * 68 + 16 * nt + 4 * q) = ai; } }
        LDS_WAIT();
        float ga[16], bg[16], cg[16], xb[16];
        if (MODE == 1) {
#pragma unroll
            for (int t = 0; t < 16; ++t) { ga[t] = bf2f(pr[t * NIN + 512]); bg[t] = bf2f(pr[t * NIN + 1024]); cg[t] = bf2f(pr[t * NIN + 1536]); xb[t] = bf2f(pr[t * NIN + 2048]); }
        }
#pragma unroll
        for (int t = 0; t < 16; ++t) {
            const float rg = sigmoid_fast(GR[t * 68 + lane] + ba), ig = sigmoid_fast(GI[t * 68 + lane] + bx);
            const float la = sp8 * rg, a = expf(la); float mult = sqrtf(-expm1f(2.0f * la));
            if (!sample && ch64 == 0 && sb == 0 && t == 0) mult = 1.0f;
            const int n = (rb + t - MP) >> 2;
            if (sample && (t & 3) == 0) h = p.state_lru_h[(size_t)(n * 2 + e) * 512 + ch];
            h = a * h + mult * (ig * xc[t]); aprod *= a;
            if (MODE == 1) {
                bf16* yr = p.Y + (size_t)(rb + t) * DM + ch;
                yr[0] = f2bf(h * gelu_fast(ga[t]));
                if (sample && (t & 3) == 0) { const float* st = p.state_sconv + (size_t)((n * 2 + e) * 2) * 512 + ch; c2 = st[0]; c1 = st[512]; }
                const float cx = cg[t] * xb[t]; yr[512] = f2bf(bg[t] * (wb0 * c2 + wb1 * c1 + wb2 * cx)); c2 = c1; c1 = cx;
                if (sample) { const int tt = t & 3;
                    if (tt >= 1) p.out[O_CAS + ((size_t)(n * 2 + e) * 3 + (tt - 1)) * 512 + ch] = xa[t];
                    if (tt >= 2) p.out[O_SCS + ((size_t)(n * 2 + e) * 2 + (tt - 2)) * 512 + ch] = cx;
                    if (tt == 3) p.out[O_HS + (size_t)(n * 2 + e) * 512 + ch] = h;
                } else if (ch64 == NCH - 1 && sb == LCH / 16 - 1) {
                    if (t >= 13) p.out[O_CAP + ((size_t)(b * 2 + e) * 3 + (t - 13)) * 512 + ch] = xa[t];
                    if (t >= 14) p.out[O_SCP + ((size_t)(b * 2 + e) * 2 + (t - 14)) * 512 + ch] = cx;
                    if (t == 15) p.out[O_HP + (size_t)(b * 2 + e) * 512 + ch] = h;
                }
            }
        }
        LDS_WAIT();
    }
    if (MODE == 0) { p.AP[((size_t)b * NCH + ch64) * 512 + ch] = aprod; p.HE[((size_t)b * NCH + ch64) * 512 + ch] = h; }
}
__device__ __forceinline__ void mixer_even(LAS unsigned char* lds, int l) {
    const int e = l / 2;
    { const Ctx c = mkctx(lds); PREF p = kparams();
      for (int u = c.gw; u < N_PU + N_SU; u += c.ngw) {
          if (u < N_PU) { const int g = u & 7, ch64 = (u >> 3) % NCH, b = (u >> 3) / NCH; lru_unit<0>(c, p, e, 0, b * SEQ + ch64 * LCH, b, ch64, g); }
          else { const int v = u - N_PU, g = v & 7, sc = v >> 3; lru_unit<1>(c, p, e, 1, MP + sc * LCH, 0, 0, g); } } }
    GRID_SYNC();
    { const Ctx c = mkctx(lds); PREF p = kparams();
      for (int u = c.gw; u < N_PU; u += c.ngw) { const int g = u & 7, ch64 = (u >> 3) % NCH, b = (u >> 3) / NCH; lru_unit<1>(c, p, e, 0, b * SEQ + ch64 * LCH, b, ch64, g); } }
    GRID_SYNC();
}
constexpr int ST = 136, SQ = 72;
constexpr int N_R1 = BATCH * NC * 4, N_RS = DECB * 4, N_GS = DECB;
__device__ __forceinline__ bf16x8 ldsfrag(const LAS bf16* base, int row, int stride, int k0) { return *(const LAS bf16x8*)(base + row * stride + k0); }
__device__ __forceinline__ float gamma_h(int h) { return 1.0f - exp2f(-5.0f - (float)h); }
__device__ __forceinline__ void lds_transpose128(const LAS bf16* NAT, LAS bf16* DST, int tid) {
    for (int it = tid; it < 8192; it += NTHR) { const int d = (it & 7) | (((it >> 6) & 15) << 3), sp = ((it >> 3) & 7) | (((it >> 10) & 7) << 3);
        const unsigned a = NAT[(2 * sp) * ST + d], b = NAT[(2 * sp + 1) * ST + d]; *(LAS unsigned*)(DST + d * ST + 2 * sp) = a | (b << 16); }
}
__device__ __forceinline__ void stage_nat128(const bf16* src, LAS bf16* NAT, int tid) {
    for (int it = tid; it < 2048; it += NTHR) { const int m = it >> 4, ck = it & 15; *(LAS u32x4*)(NAT + m * ST + 8 * ck) = *(const u32x4*)(src + (size_t)m * NIN + 8 * ck); }
}
__device__ __forceinline__ void r1_unit(const Ctx& c, PREF p, int o, int b, int ck, int j) {
    const int tid = c.tid, lane = c.lane, q = lane >> 4, r16 = lane & 15, w = c.wave, row0 = b * SEQ + ck * 128;
    LAS bf16* NAT = (LAS bf16*)c.lds; LAS bf16* VT = (LAS bf16*)(c.lds + 34816); LAS bf16* KT = (LAS bf16*)(c.lds + 69632);
    stage_nat128(p.PROJ + (size_t)row0 * NIN + 512 + j * 128, NAT, tid);
    { const float lg = lgam(j);
      for (int it = tid; it < 2048; it += NTHR) { const int i = it & 31, mp = it >> 5; float av[2], bv[2];
#pragma unroll
          for (int s = 0; s < 2; ++s) { const int m = 2 * mp + s; const float* cs = p.rope + ((size_t)(ck * 128 + m) * 32 + i) * 2; const float cc = cs[0], sn = cs[1];
              const bf16* pr = p.PROJ + (size_t)(row0 + m) * NIN + 256 + j * 64 + i; const float k1 = bf2f(pr[0]), k2 = bf2f(pr[32]), f = 0.125f * expf(-(float)m * lg);
              av[s] = (k1 * cc - k2 * sn) * f; bv[s] = (k1 * sn + k2 * cc) * f; }
          *(LAS unsigned*)(KT + i * ST + 2 * mp) = pk2(av[0], av[1]); *(LAS unsigned*)(KT + (i + 32) * ST + 2 * mp) = pk2(bv[0], bv[1]); } }
    __syncthreads();
    lds_transpose128(NAT, VT, tid);
    __syncthreads();
    { bf16x8 yv[4];
#pragma unroll
      for (int ks = 0; ks < 4; ++ks) yv[ks] = ldsfrag(VT, 16 * w + r16, ST, ks * 32 + 8 * q);
      const float g127 = gpow(j, 127); float* kv = p.KVT + ((size_t)(b * NC + ck) * 4 + j) * 8192 + (16 * w + r16) * 64 + 4 * q;
#pragma unroll
      for (int dt = 0; dt < 4; ++dt) { f32x4 acc = {0.f, 0.f, 0.f, 0.f};
#pragma unroll
          for (int ks = 0; ks < 4; ++ks) acc = __builtin_amdgcn_mfma_f32_16x16x32_bf16(ldsfrag(KT, 16 * dt + r16, ST, ks * 32 + 8 * q), yv[ks], acc, 0, 0, 0);
          *(f32x4*)(kv + 16 * dt) = acc * g127; } }
    __syncthreads();
    LAS bf16* VdT = VT; LAS bf16* WL = KT;
    { f32x4 g0 = *(const f32x4*)(p.gm_ln_g + o * 512 + 8 * lane), g1 = *(const f32x4*)(p.gm_ln_g + o * 512 + 8 * lane + 4), b0 = *(const f32x4*)(p.gm_ln_b + o * 512 + 8 * lane), b1 = *(const f32x4*)(p.gm_ln_b + o * 512 + 8 * lane + 4);
      for (int rr = 0; rr < 16; ++rr) { const int row = 16 * w + rr; const u32x4 raw = *(const u32x4*)(p.PROJ + (size_t)(row0 + row) * NIN + 2048 + 8 * lane);
          float v[8]; v[0] = gelu_fast(bf2f((bf16)(raw.x & 0xffff))); v[1] = gelu_fast(bf2f((bf16)(raw.x >> 16))); v[2] = gelu_fast(bf2f((bf16)(raw.y & 0xffff))); v[3] = gelu_fast(bf2f((bf16)(raw.y >> 16)));
          v[4] = gelu_fast(bf2f((bf16)(raw.z & 0xffff))); v[5] = gelu_fast(bf2f((bf16)(raw.z >> 16))); v[6] = gelu_fast(bf2f((bf16)(raw.w & 0xffff))); v[7] = gelu_fast(bf2f((bf16)(raw.w >> 16)));
          float s = 0.f;
#pragma unroll
          for (int k = 0; k < 8; ++k) s += v[k];
          const float mean = wave_sum(s) * (1.0f / 512); float s2 = 0.f;
#pragma unroll
          for (int k = 0; k < 8; ++k) { v[k] -= mean; s2 += v[k] * v[k]; }
          const float rstd = 1.0f / sqrtf(wave_sum(s2) * (1.0f / 512) + LN_EPS);
          if (q == j) { u32x4 o4; o4.x = pk2(v[0] * rstd * g0.x + b0.x, v[1] * rstd * g0.y + b0.y); o4.y = pk2(v[2] * rstd * g0.z + b0.z, v[3] * rstd * g0.w + b0.w);
              o4.z = pk2(v[4] * rstd * g1.x + b1.x, v[5] * rstd * g1.y + b1.y); o4.w = pk2(v[6] * rstd * g1.z + b1.z, v[7] * rstd * g1.w + b1.w);
              *(LAS u32x4*)(NAT + row * ST + 8 * r16) = o4; } } }
    { const bf16* wsrc = p.Wtril + (size_t)((o * 4 + j) * 128) * 128;
      for (int it = tid; it < 2048; it += NTHR) { const int t = it >> 4, ck2 = it & 15; *(LAS u32x4*)(WL + t * ST + 8 * ck2) = *(const u32x4*)(wsrc + t * 128 + 8 * ck2); } }
    __syncthreads();
    lds_transpose128(NAT, VdT, tid);
    __syncthreads();
    { const int nks = (w >> 1) + 1, t = 16 * w + r16; bf16x8 yw[4];
#pragma unroll
      for (int ks = 0; ks < 4; ++ks) yw[ks] = ldsfrag(WL, t, ST, ks * 32 + 8 * q);
      const float sb = p.sp_b[(o * 4 + j) * 128 + t];
      const bf16* ur = p.PROJ + (size_t)(row0 + t) * NIN + 1536 + j * 128 + 4 * q; bf16* yr = p.Y + (size_t)(row0 + t) * DM + 512 + j * 128 + 4 * q;
#pragma unroll
      for (int dt = 0; dt < 8; ++dt) { f32x4 acc = {0.f, 0.f, 0.f, 0.f};
#pragma unroll
          for (int ks = 0; ks < 4; ++ks) if (ks < nks) acc = __builtin_amdgcn_mfma_f32_16x16x32_bf16(ldsfrag(VdT, 16 * dt + r16, ST, ks * 32 + 8 * q), yw[ks], acc, 0, 0, 0);
          const u32x2 uu = *(const u32x2*)(ur + 16 * dt);
          u32x2 o2; o2.x = pk2(gelu_fast(bf2f((bf16)(uu.x & 0xffff))) * (acc.x + sb), gelu_fast(bf2f((bf16)(uu.x >> 16))) * (acc.y + sb));
          o2.y = pk2(gelu_fast(bf2f((bf16)(uu.y & 0xffff))) * (acc.z + sb), gelu_fast(bf2f((bf16)(uu.y >> 16))) * (acc.w + sb));
          *(u32x2*)(yr + 16 * dt) = o2; } }
    __syncthreads();
}
__device__ __forceinline__ void r2_unit(const Ctx& c, PREF p, int o, int b, int ck, int h) {
    const int tid = c.tid, lane = c.lane, q = lane >> 4, r16 = lane & 15, w = c.wave, row0 = b * SEQ + ck * 128;
    LAS bf16* QL = (LAS bf16*)c.lds; LAS bf16* KL = (LAS bf16*)(c.lds + 18432); LAS bf16* S0T = (LAS bf16*)(c.lds + 36864); LAS bf16* VT = (LAS bf16*)(c.lds + 55296); LAS bf16* PM = (LAS bf16*)(c.lds + 90112);
    LAS bf16* NAT = PM;
    stage_nat128(p.PROJ + (size_t)row0 * NIN + 512 + h * 128, NAT, tid);
    { const float lg = lgam(h);
      for (int it = tid; it < 4096; it += NTHR) { const int i = it & 31, m = it >> 5; const float* cs = p.rope + ((size_t)(ck * 128 + m) * 32 + i) * 2; const float cc = cs[0], sn = cs[1];
          const bf16* pr = p.PROJ + (size_t)(row0 + m) * NIN + h * 64 + i; const float q1 = bf2f(pr[0]), q2 = bf2f(pr[32]), k1 = bf2f(pr[256]), k2 = bf2f(pr[288]);
          const float gl = expf((float)m * lg), gk = 0.125f * expf(-(float)m * lg);
          QL[m * SQ + i] = f2bf((q1 * cc - q2 * sn) * gl); QL[m * SQ + i + 32] = f2bf((q1 * sn + q2 * cc) * gl);
          KL[m * SQ + i] = f2bf((k1 * cc - k2 * sn) * gk); KL[m * SQ + i + 32] = f2bf((k1 * sn + k2 * cc) * gk); } }
    { const float g128 = gpow(h, 128);
      for (int k = 0; k < 16; ++k) { const int idx = tid + NTHR * k, e = idx >> 6, d = idx & 63; float S = 0.f;
          for (int jc = 0; jc < ck; ++jc) S = g128 * S + p.KVT[((size_t)(b * NC + jc) * 4 + h) * 8192 + idx];
          S0T[e * SQ + d] = f2bf(S);
          if (ck == NC - 1) { S = g128 * S + p.KVT[((size_t)(b * NC + ck) * 4 + h) * 8192 + idx]; p.out[O_RP + ((size_t)(b * 2 + o) * 4 + h) * 8192 + d * 128 + e] = S; } } }
    __syncthreads();
    lds_transpose128(NAT, VT, tid);
    __syncthreads();
    const int l = 16 * w + r16; bf16x8 yq[2];
#pragma unroll
    for (int ks = 0; ks < 2; ++ks) yq[ks] = ldsfrag(QL, l, SQ, ks * 32 + 8 * q);
#pragma unroll
    for (int mt = 0; mt < 8; ++mt) { f32x4 acc = {0.f, 0.f, 0.f, 0.f};
        if (mt <= w) {
#pragma unroll
            for (int ks = 0; ks < 2; ++ks) acc = __builtin_amdgcn_mfma_f32_16x16x32_bf16(ldsfrag(KL, 16 * mt + r16, SQ, ks * 32 + 8 * q), yq[ks], acc, 0, 0, 0);
            const int mb = 16 * mt + 4 * q;
            acc.x = (mb + 0 <= l) ? acc.x : 0.f; acc.y = (mb + 1 <= l) ? acc.y : 0.f; acc.z = (mb + 2 <= l) ? acc.z : 0.f; acc.w = (mb + 3 <= l) ? acc.w : 0.f; }
        u32x2 o2; o2.x = pk2(acc.x, acc.y); o2.y = pk2(acc.z, acc.w); *(LAS u32x2*)(PM + l * ST + 16 * mt + 4 * q) = o2; }
    LDS_WAIT();
    bf16x8 yp[4];
#pragma unroll
    for (int ks = 0; ks < 4; ++ks) yp[ks] = ldsfrag(PM, l, ST, ks * 32 + 8 * q);
    const int nks = (w >> 1) + 1; const float gam = gamma_h(h);
    f32x4 ov[8]; float s = 0.f;
#pragma unroll
    for (int et = 0; et < 8; ++et) { f32x4 acc = {0.f, 0.f, 0.f, 0.f};
#pragma unroll
        for (int ks = 0; ks < 2; ++ks) acc = __builtin_amdgcn_mfma_f32_16x16x32_bf16(ldsfrag(S0T, 16 * et + r16, SQ, ks * 32 + 8 * q), yq[ks], acc, 0, 0, 0);
        acc = acc * gam;
#pragma unroll
        for (int ks = 0; ks < 4; ++ks) if (ks < nks) acc = __builtin_amdgcn_mfma_f32_16x16x32_bf16(ldsfrag(VT, 16 * et + r16, ST, ks * 32 + 8 * q), yp[ks], acc, 0, 0, 0);
        ov[et] = acc; s += (acc.x + acc.y) + (acc.z + acc.w); }
    s += __shfl_xor(s, 16); s += __shfl_xor(s, 32);
    const float mean = s * (1.0f / 128); float s2 = 0.f;
#pragma unroll
    for (int et = 0; et < 8; ++et) { ov[et] = ov[et] - mean; s2 += (ov[et].x * ov[et].x + ov[et].y * ov[et].y) + (ov[et].z * ov[et].z + ov[et].w * ov[et].w); }
    s2 += __shfl_xor(s2, 16); s2 += __shfl_xor(s2, 32);
    const float rstd = 1.0f / sqrtf(s2 * (1.0f / 128) + LN_EPS);
    { const bf16* gr = p.PROJ + (size_t)(row0 + l) * NIN + 1024 + h * 128 + 4 * q; bf16* yr = p.Y + (size_t)(row0 + l) * DM + h * 128 + 4 * q; const float* gn = p.ret_gn_g + o * 512 + h * 128 + 4 * q;
#pragma unroll
      for (int et = 0; et < 8; ++et) { const u32x2 gg = *(const u32x2*)(gr + 16 * et); const f32x4 gw = *(const f32x4*)(gn + 16 * et); const f32x4 v = ov[et] * rstd * gw;
          u32x2 o2; o2.x = pk2(silu_fast(bf2f((bf16)(gg.x & 0xffff))) * v.x, silu_fast(bf2f((bf16)(gg.x >> 16))) * v.y);
          o2.y = pk2(silu_fast(bf2f((bf16)(gg.y & 0xffff))) * v.z, silu_fast(bf2f((bf16)(gg.y >> 16))) * v.w);
          *(u32x2*)(yr + 16 * et) = o2; } }
    __syncthreads();
}
__device__ __forceinline__ void rs_unit(const Ctx& c, PREF p, int o, int n, int h) {
    const int tid = c.tid, lane = c.lane, row0 = MP + n * 4;
    LAS float* QS = (LAS float*)c.lds; LAS float* KS = QS + 256; LAS float* VS = QS + 512; LAS float* SC = QS + 1024; LAS float* CR = QS + 1056; LAS float* RED = QS + 1056 + 2048;
    if (tid < 128) { const int l = tid >> 5, i = tid & 31; const float* cs = p.rope + ((size_t)(SEQ + l) * 32 + i) * 2; const float cc = cs[0], sn = cs[1];
        const bf16* pr = p.PROJ + (size_t)(row0 + l) * NIN + h * 64 + i; const float q1 = bf2f(pr[0]), q2 = bf2f(pr[32]), k1 = bf2f(pr[256]), k2 = bf2f(pr[288]);
        QS[l * 64 + i] = q1 * cc - q2 * sn; QS[l * 64 + i + 32] = q1 * sn + q2 * cc; KS[l * 64 + i] = 0.125f * (k1 * cc - k2 * sn); KS[l * 64 + i + 32] = 0.125f * (k1 * sn + k2 * cc); }
    { const int l = tid >> 7, e = tid & 127; VS[l * 128 + e] = bf2f(p.PROJ[(size_t)(row0 + l) * NIN + 512 + h * 128 + e]); }
    __syncthreads();
    if (tid < 16) { const int l = tid >> 2, m = tid & 3; float v = 0.f; if (m <= l) { float dot = 0.f; for (int d = 0; d < 64; ++d) dot += QS[l * 64 + d] * KS[m * 64 + d]; v = dot * gpow(h, l - m); } SC[tid] = v; }
    { const int e = tid & 127, dg = tid >> 7; const size_t base = ((size_t)(n * 2 + o) * 4 + h) * 8192; const float g4 = gpow(h, 4), k0 = gpow(h, 3), k1 = gpow(h, 2), k2 = gpow(h, 1);
      float cr0 = 0.f, cr1 = 0.f, cr2 = 0.f, cr3 = 0.f; const float v0 = VS[e], v1 = VS[128 + e], v2 = VS[256 + e], v3 = VS[384 + e];
      for (int dd = 0; dd < 16; ++dd) { const int d = dg * 16 + dd; const float s0 = p.state_ret[base + d * 128 + e];
          p.out[O_RS + base + d * 128 + e] = g4 * s0 + k0 * KS[d] * v0 + k1 * KS[64 + d] * v1 + k2 * KS[128 + d] * v2 + KS[192 + d] * v3;
          cr0 += QS[d] * s0; cr1 += QS[64 + d] * s0; cr2 += QS[128 + d] * s0; cr3 += QS[192 + d] * s0; }
      CR[(dg * 4 + 0) * 128 + e] = cr0; CR[(dg * 4 + 1) * 128 + e] = cr1; CR[(dg * 4 + 2) * 128 + e] = cr2; CR[(dg * 4 + 3) * 128 + e] = cr3; }
    __syncthreads();
    { const int l = tid >> 7, e = tid & 127; float ovv = (CR[(0 + l) * 128 + e] + CR[(4 + l) * 128 + e] + CR[(8 + l) * 128 + e] + CR[(12 + l) * 128 + e]) * gpow(h, l + 1);
      for (int m = 0; m <= l; ++m) ovv += SC[l * 4 + m] * VS[m * 128 + e];
      const float s = wave_sum(ovv); if (lane == 0) RED[c.wave] = s;
      __syncthreads();
      const float mean = (RED[2 * l] + RED[2 * l + 1]) * (1.0f / 128), d = ovv - mean; const float s2 = wave_sum(d * d); if (lane == 0) RED[8 + c.wave] = s2;
      __syncthreads();
      const float rstd = 1.0f / sqrtf((RED[8 + 2 * l] + RED[8 + 2 * l + 1]) * (1.0f / 128) + LN_EPS);
      const float gt = bf2f(p.PROJ[(size_t)(row0 + l) * NIN + 1024 + h * 128 + e]);
      p.Y[(size_t)(row0 + l) * DM + h * 128 + e] = f2bf(silu_fast(gt) * d * rstd * p.ret_gn_g[o * 512 + h * 128 + e]); }
    __syncthreads();
}
__device__ __forceinline__ void gs_unit(const Ctx& c, PREF p, int o, int n) {
    const int ch = c.tid, g = ch >> 7, lane = c.lane, row0 = MP + n * 4; LAS float* RED = (LAS float*)c.lds;
    float v[4], mean[4], rstd[4];
#pragma unroll
    for (int t = 0; t < 4; ++t) { v[t] = gelu_fast(bf2f(p.PROJ[(size_t)(row0 + t) * NIN + 2048 + ch])); const float s = wave_sum(v[t]); if (lane == 0) RED[t * 8 + c.wave] = s; }
    __syncthreads();
#pragma unroll
    for (int t = 0; t < 4; ++t) { float s = 0.f; for (int k = 0; k < 8; ++k) s += RED[t * 8 + k]; mean[t] = s * (1.0f / 512); v[t] -= mean[t]; }
    __syncthreads();
#pragma unroll
    for (int t = 0; t < 4; ++t) { const float s2 = wave_sum(v[t] * v[t]); if (lane == 0) RED[t * 8 + c.wave] = s2; }
    __syncthreads();
    const float gg = p.gm_ln_g[o * 512 + ch], bb = p.gm_ln_b[o * 512 + ch];
#pragma unroll
    for (int t = 0; t < 4; ++t) { float s = 0.f; for (int k = 0; k < 8; ++k) s += RED[t * 8 + k]; rstd[t] = 1.0f / sqrtf(s * (1.0f / 512) + LN_EPS); v[t] = v[t] * rstd[t] * gg + bb;
        p.out[O_CV + ((size_t)(n * 2 + o) * 4 + t) * 512 + ch] = v[t]; }
#pragma unroll
    for (int t = 0; t < 4; ++t) { float s = p.sp_b[(o * 4 + g) * 128 + t]; const float* wr = p.sp_w + ((size_t)(o * 4 + g) * 128 + t) * 128;
#pragma unroll
        for (int s2 = 0; s2 < 4; ++s2) if (s2 <= t) s += wr[s2] * v[s2];
        p.Y[(size_t)(row0 + t) * DM + 512 + ch] = f2bf(gelu_fast(bf2f(p.PROJ[(size_t)(row0 + t) * NIN + 1536 + ch])) * s); }
    __syncthreads();
}
__device__ __forceinline__ void mixer_odd(LAS unsigned char* lds, int l) {
    const int o = l / 2;
    { const Ctx c = mkctx(lds); PREF p = kparams();
      for (int u = (int)blockIdx.x; u < N_R1 + N_RS + N_GS; u += (int)gridDim.x) {
          if (u < N_R1) r1_unit(c, p, o, u / (NC * 4), (u >> 2) % NC, u & 3);
          else if (u < N_R1 + N_RS) { const int v = u - N_R1; rs_unit(c, p, o, v >> 2, v & 3); }
          else gs_unit(c, p, o, u - N_R1 - N_RS); } }
    GRID_SYNC();
    { const Ctx c = mkctx(lds); PREF p = kparams();
      for (int u = (int)blockIdx.x; u < N_R1; u += (int)gridDim.x) r2_unit(c, p, o, u / (NC * 4), (u >> 2) % NC, u & 3); }
    GRID_SYNC();
}
__device__ __forceinline__ void mixer_phases(LAS unsigned char* lds, int l) {
#ifdef FAST_EVEN
    if (l % 2 == 0) { mixer_even(lds, l); return; }
#endif
#ifdef FAST_ODD
    if (l % 2 == 1) { mixer_odd(lds, l); return; }
#endif
    for (int grp = 0; grp <= BATCH; ++grp) {
        const int sample = grp == BATCH, r0 = sample ? MP : grp * SEQ, nr = sample ? MS : SEQ, T = sample ? DECS : SEQ, nseq = sample ? DECB : 1;
        if (l % 2 == 0) { const int e = l / 2;
            run_simple(FE1{kparams(), e, r0}, (long)nr * 512); GRID_SYNC(); run_simple(FE2{kparams(), e, r0}, (long)nr * 512); GRID_SYNC();
            run_simple(FE3{kparams(), e, r0, T, sample}, (long)nseq * 512); GRID_SYNC(); run_simple(FE4{kparams(), e, r0}, (long)nr * 512); GRID_SYNC();
        } else { const int o = l / 2;
            run_simple(FO1{kparams(), r0}, (long)nr * 128); GRID_SYNC();
            if (!sample) { run_simple(FO2{kparams(), grp}, (long)NC * 32768); GRID_SYNC(); run_simple(FO3{kparams(), grp, o}, 32768L); GRID_SYNC();
                run_simple(FO4{kparams()}, (long)NC * 65536); GRID_SYNC(); run_simple(FO5{kparams(), grp}, (long)NC * 65536); GRID_SYNC(); }
            else { run_simple(FO5s{kparams(), o}, (long)DECB * 2048); GRID_SYNC(); run_simple(FO3s{kparams(), o}, (long)DECB * 32768); GRID_SYNC(); }
            run_simple(FO6{kparams(), o, r0}, (long)nr * 4); GRID_SYNC(); run_simple(FO7{kparams(), o, r0}, (long)nr); GRID_SYNC(); run_simple(FO8{kparams(), o, r0}, (long)nr * 512); GRID_SYNC();
        }
    }
}

__global__ void __launch_bounds__(NTHR, 2) fwd_megakernel(P p_unused) {
    extern __shared__ __attribute__((aligned(16))) unsigned char lds_raw[];
    LAS unsigned char* lds = (LAS unsigned char*)lds_raw;
    for (int u = threadIdx.x; u < 64; u += NTHR) ((LAS unsigned*)(lds + MISC_OFF))[u] = 0u;
    if (blockIdx.x == 0) for (int u = threadIdx.x; u < XCD_BAR_WORDS; u += NTHR) __hip_atomic_store((unsigned*)(kparams().ws + WS_CTL) + u, 0u, __ATOMIC_RELAXED, __HIP_MEMORY_SCOPE_AGENT);
    __syncthreads();
    { const Ctx c = mkctx(lds); phase_prep(c); }
    cg::this_grid().sync();
    (void)xcd_barrier_post((unsigned*)(kparams().ws + WS_CTL), (volatile LAS unsigned*)(lds + MISC_OFF) + 8);
#ifdef PROBE_PREP
    { const Ctx c = mkctx(lds); phase_prep(c); }
    GRID_SYNC();
#endif
#ifdef PROBE_SYNC
    for (int i = 0; i < PROBE_SYNC; ++i) GRID_SYNC();
#endif
    for (int l = 0; l < DEPTH; ++l) {
        { const Ctx c = mkctx(lds); PREF p = kparams(); phase_gemm(c, p.XB, p.Wt_in + (size_t)l * NIN * DM, M, NIN, DM, pg8::EpiProj{p.PROJ, NIN}); }
        GRID_SYNC();
#ifdef PROBE_G1
        { const Ctx c = mkctx(lds); PREF p = kparams(); phase_gemm(c, p.XB, p.Wt_in + (size_t)l * NIN * DM, M, NIN, DM, pg8::EpiProj{p.PROJ, NIN}); }
        GRID_SYNC();
#endif
        mixer_phases(lds, l);
#ifdef PROBE_EVEN
        if (l % 2 == 0) mixer_phases(lds, l);
#endif
#ifdef PROBE_ODD
        if (l % 2 == 1) mixer_phases(lds, l);
#endif
        { const Ctx c = mkctx(lds); PREF p = kparams(); phase_gemm(c, p.Y, p.Wt_out + (size_t)l * DM * DM, MP, DM, DM, pg8::EpiRes{p.XF, DM, ALPHA});
          sample_gemm_tail(c, p.Y, p.Wt_out + (size_t)l * DM * DM, DM, p.XF, ALPHA); }
        GRID_SYNC();
        { const Ctx c = mkctx(lds); PREF p = kparams(); phase_ln(c, p.ln1_g + l * DM, p.ln1_b + l * DM); }
        GRID_SYNC();
        { const Ctx c = mkctx(lds); PREF p = kparams(); phase_gemm(c, p.XB, p.Wt_13 + (size_t)l * 2 * DFF * DM, M, 2 * DFF, DM, pg8::EpiSwiglu{p.H, DFF}); }
        GRID_SYNC();
#ifdef PROBE_G3
        { const Ctx c = mkctx(lds); PREF p = kparams(); phase_gemm(c, p.XB, p.Wt_13 + (size_t)l * 2 * DFF * DM, M, 2 * DFF, DM, pg8::EpiSwiglu{p.H, DFF}); }
        GRID_SYNC();
#endif
        { const Ctx c = mkctx(lds); PREF p = kparams(); phase_gemm(c, p.H, p.Wt_2 + (size_t)l * DM * DFF, MP, DM, DFF, pg8::EpiRes{p.XF, DM, ALPHA});
          sample_gemm_tail(c, p.H, p.Wt_2 + (size_t)l * DM * DFF, DFF, p.XF, ALPHA); }
        GRID_SYNC();
        { const Ctx c = mkctx(lds); PREF p = kparams(); phase_ln(c, p.ln2_g + l * DM, p.ln2_b + l * DM); }
        GRID_SYNC();
    }
}
extern "C" void kernel_launch(void* const* d_in, const int* in_sizes, int n_in, void* d_out, int out_size, void* d_ws, size_t ws_size, hipStream_t stream) {
    if (n_in != 30 || (long)out_size != O_END || ws_size < WS_END) { fprintf(stderr, "kernel_launch: unexpected shapes n_in %d out %d (want %ld) ws %zu (want %zu)\n", n_in, out_size, O_END, ws_size, (size_t)WS_END); return; }
    static int grid = 0;
    if (grid == 0) {
        int dev = 0, cus = 0, per_cu = 0;
        (void)hipGetDevice(&dev); (void)hipDeviceGetAttribute(&cus, hipDeviceAttributeMultiprocessorCount, dev);
        (void)hipFuncSetAttribute((const void*)fwd_megakernel, hipFuncAttributeMaxDynamicSharedMemorySize, LDS_BYTES);
        (void)hipOccupancyMaxActiveBlocksPerMultiprocessor(&per_cu, (const void*)fwd_megakernel, NTHR, LDS_BYTES);
        if (per_cu < 1) fprintf(stderr, "kernel_launch: occupancy query says %d blocks/CU\n", per_cu);
        grid = cus;
        (void)hipGetLastError();
    }
    P p{}; setup_P(p, d_in, d_out, d_ws);
    void* args[] = {&p};
    hipError_t e = hipLaunchCooperativeKernel((const void*)fwd_megakernel, dim3(grid), dim3(NTHR), args, LDS_BYTES, stream);
    if (e != hipSuccess) fprintf(stderr, "cooperative launch failed: %s (grid %d)\n", hipGetErrorString(e), grid);
}
```

```cpp
#include <hip/hip_runtime.h>
#include <cstdio>
#include <cstdint>
#define HD __host__ __device__ __forceinline__
#define CONSTAS __attribute__((address_space(4)))
#ifndef T_BATCH
#define T_BATCH 8
#endif
#ifndef T_SEQ
#define T_SEQ 2048
#endif
#ifndef T_DEC
#define T_DEC 128
#endif
typedef unsigned short bf16;
#ifndef CONSTAS
#define CONSTAS
#endif
#define PREF const CONSTAS P&
constexpr int BATCH = T_BATCH, SEQ = T_SEQ, DECB = T_DEC, DECS = 4, DM = 1024, DEPTH = 4;
constexpr int NIN = 2560, DFF = 2816, NC = SEQ / 128, PAST = 16384;
constexpr int MP = BATCH * SEQ, MS = DECB * DECS, M = MP + MS;
constexpr float ALPHA = 1.681792830507429f, LN_EPS = 1e-5f;
constexpr long O_Y = 0, O_HP = (long)M * DM, O_HS = O_HP + (long)BATCH * 1024, O_CAP = O_HS + (long)DECB * 1024, O_CAS = O_CAP + (long)BATCH * 3072,
               O_SCP = O_CAS + (long)DECB * 3072, O_SCS = O_SCP + (long)BATCH * 2048, O_RP = O_SCS + (long)DECB * 2048, O_RS = O_RP + (long)BATCH * 65536,
               O_CV = O_RS + (long)DECB * 65536, O_END = O_CV + (long)DECB * 4096;
constexpr size_t al256(size_t x) { return (x + 255) & ~(size_t)255; }
constexpr size_t WS_CTL = 0, WS_WIN = 1u << 20, WS_WOUT = WS_WIN + (size_t)4 * NIN * DM * 2, WS_W13 = WS_WOUT + (size_t)4 * DM * DM * 2,
                 WS_W2 = WS_W13 + (size_t)4 * 2 * DFF * DM * 2, WS_XB = WS_W2 + (size_t)4 * DM * DFF * 2, WS_PROJ = al256(WS_XB + (size_t)M * DM * 2),
                 WS_Y = al256(WS_PROJ + (size_t)M * NIN * 2), WS_ROPE = al256(WS_Y + (size_t)M * DM * 2), WS_WAT = al256(WS_ROPE + (size_t)(SEQ + 4) * 64 * 4), WS_WXT = WS_WAT + 131072, WS_AP = WS_WXT + 131072,
                 WS_HE = WS_AP + (size_t)BATCH * (SEQ / 64) * 512 * 4, WS_WTRIL = WS_HE + (size_t)BATCH * (SEQ / 64) * 512 * 4, WS_KVT = WS_WTRIL + (size_t)2 * 4 * 128 * 128 * 2,
                 WS_SCR = al256(WS_KVT + (size_t)BATCH * NC * 4 * 8192 * 4);
constexpr size_t WS_H = WS_PROJ;
static_assert((size_t)M * DFF * 2 <= WS_ROPE - WS_PROJ, "H overlay");
constexpr int GR = (SEQ > MS ? SEQ : MS);
constexpr size_t SCR_A = 0, SCR_B = SCR_A + (size_t)GR * 512 * 4, SCR_C = SCR_B + (size_t)GR * 512 * 4, SCR_D = SCR_C + (size_t)GR * 512 * 4,
                 SCR_E = SCR_D + (size_t)NC * 4 * 8192 * 4, SCR_F = SCR_E + (size_t)NC * 4 * 8192 * 4, SCR_END = SCR_F + (size_t)NC * 4 * 16384 * 4;
constexpr size_t WS_END = WS_SCR + SCR_END;

struct P {
    const float *x_prompt, *x_sample, *state_lru_h, *state_lru_conv, *state_sconv, *state_ret;
    const float *w_in_even, *conv_a_w, *conv_a_b, *lru_wa, *lru_ba, *lru_wx, *lru_bx, *lru_lam, *conv_b_w, *w_out_even;
    const float *w_in_odd, *ret_gn_g, *sp_w, *sp_b, *gm_ln_g, *gm_ln_b, *w_out_odd;
    const float *ffn_w1, *ffn_w3, *ffn_w2, *ln1_g, *ln1_b, *ln2_g, *ln2_b;
    float* out; unsigned char* ws;
    bf16 *Wt_in, *Wt_out, *Wt_13, *Wt_2, *XB, *PROJ, *Y, *H;
    float *XF, *rope, *sA, *sB, *sC, *sD, *sE, *sF;
    bf16 *WaT, *WxT, *Wtril; float *AP, *HE, *KVT;
};
static inline void setup_P(P& p, void* const* d_in, void* d_out, void* d_ws) {
    const float** f = (const float**)&p.x_prompt;
    for (int i = 0; i < 30; ++i) f[i] = (const float*)d_in[i];
    p.out = (float*)d_out; p.ws = (unsigned char*)d_ws;
    p.Wt_in = (bf16*)(p.ws + WS_WIN); p.Wt_out = (bf16*)(p.ws + WS_WOUT); p.Wt_13 = (bf16*)(p.ws + WS_W13); p.Wt_2 = (bf16*)(p.ws + WS_W2);
    p.XB = (bf16*)(p.ws + WS_XB); p.PROJ = (bf16*)(p.ws + WS_PROJ); p.Y = (bf16*)(p.ws + WS_Y); p.H = (bf16*)(p.ws + WS_H);
    p.XF = p.out; p.rope = (float*)(p.ws + WS_ROPE);
    p.WaT = (bf16*)(p.ws + WS_WAT); p.WxT = (bf16*)(p.ws + WS_WXT); p.Wtril = (bf16*)(p.ws + WS_WTRIL); p.AP = (float*)(p.ws + WS_AP); p.HE = (float*)(p.ws + WS_HE); p.KVT = (float*)(p.ws + WS_KVT);
    unsigned char* s = p.ws + WS_SCR;
    p.sA = (float*)(s + SCR_A); p.sB = (float*)(s + SCR_B); p.sC = (float*)(s + SCR_C); p.sD = (float*)(s + SCR_D); p.sE = (float*)(s + SCR_E); p.sF = (float*)(s + SCR_F);
}

HD bf16 f2bf(float f) { unsigned u = __builtin_bit_cast(unsigned, f); return (bf16)((u + 0x7fffu + ((u >> 16) & 1u)) >> 16); }
HD float bf2f(bf16 h) { return __builtin_bit_cast(float, (unsigned)h << 16); }
HD float sigmoidf_(float x) { return 1.0f / (1.0f + expf(-x)); }
HD float siluf_(float x) { return x * sigmoidf_(x); }
HD float geluf_(float x) { return 0.5f * x * (1.0f + tanhf(0.7978845608028654f * (x + 0.044715f * x * x * x))); }
HD float lgam(int h) { return h == 0 ? -0.0317486983145803f : h == 1 ? -0.015748356968139168f : h == 2 ? -0.007843177461025893f : -0.003913899321136329f; }
HD float gpow(int h, int n) { return expf((float)n * lgam(h)); }
struct RowInfo { int sample, s, t, T, base; };
HD RowInfo rowinfo(int row) { RowInfo r; if (row < MP) { r.sample = 0; r.s = row / SEQ; r.t = row % SEQ; r.T = SEQ; r.base = r.s * SEQ; } else { int q = row - MP; r.sample = 1; r.s = q / DECS; r.t = q % DECS; r.T = DECS; r.base = MP + r.s * DECS; } return r; }

struct FPrepW { const float* W; bf16* Wt; int K, N;
    HD void operator()(long g) const { int n = (int)(g / K), k = (int)(g % K); Wt[g] = f2bf(W[(long)k * N + n]); } };
struct FPrepW13 { const float* W; bf16* Wt; int half, pad_;
    HD void operator()(long g) const { int j = (int)(g / DM), k = (int)(g % DM); Wt[(long)((j >> 7) * 256 + half * 128 + (j & 127)) * DM + k] = f2bf(W[(long)k * DFF + j]); } };
struct FPrepX { PREF p;
    HD void operator()(long g) const { float v = g < (long)MP * DM ? p.x_prompt[g] : p.x_sample[g - (long)MP * DM]; p.XF[g] = v; p.XB[g] = f2bf(v); } };
struct FRope { float* cs;
    HD void operator()(long g) const { int pi = (int)(g / 32), i = (int)(g % 32); double pos = pi < SEQ ? (double)pi : (double)(PAST + pi - SEQ);
        double fr = 1.0; for (int j = 0; j < i; ++j) fr *= 0.7498942093324559;
        double ang = pos * fr, k = rint(ang * 0.15915494309189535), r = ang - k * 6.283185307179586; r -= k * 2.4492935982947064e-16;
        double r2 = r * r, sn = 0.0, cn = 0.0;
        for (int n = 14; n >= 1; --n) { sn = (sn + 1.0) * (-r2 / ((2.0 * n) * (2.0 * n + 1.0))); cn = (cn + 1.0) * (-r2 / ((2.0 * n - 1.0) * (2.0 * n))); }
        cs[2 * g] = (float)(cn + 1.0); cs[2 * g + 1] = (float)(r * (sn + 1.0)); } };

struct FLN { PREF p; const float* g; const float* b;
    HD void operator()(long row) const { float* z = p.XF + row * DM; float mu = 0.f; for (int c = 0; c < DM; ++c) mu += z[c]; mu *= (1.0f / DM);
        float var = 0.f; for (int c = 0; c < DM; ++c) { float d = z[c] - mu; var += d * d; } var *= (1.0f / DM); float rs = 1.0f / sqrtf(var + LN_EPS);
        for (int c = 0; c < DM; ++c) { float v = (z[c] - mu) * rs * g[c] + b[c]; z[c] = v; p.XB[row * DM + c] = f2bf(v); } } };

struct FE1 { PREF p; int e, r0;
    HD void operator()(long g) const { int row = r0 + (int)(g / 512), ch = (int)(g % 512); RowInfo ri = rowinfo(row);
        float acc = p.conv_a_b[e * 512 + ch];
        for (int j = 0; j < 4; ++j) { int tt = ri.t - 3 + j; float xv;
            if (tt >= 0) xv = bf2f(p.PROJ[(long)(ri.base + tt) * NIN + ch]); else xv = ri.sample ? p.state_lru_conv[((long)(ri.s * 2 + e) * 3 + (3 + tt)) * 512 + ch] : 0.f;
            acc += p.conv_a_w[(e * 4 + j) * 512 + ch] * xv; }
        p.sA[g] = acc;
        if (ri.t >= ri.T - 3) { float xv = bf2f(p.PROJ[(long)row * NIN + ch]); int j = ri.t - (ri.T - 3);
            p.out[(ri.sample ? O_CAS : O_CAP) + ((long)(ri.s * 2 + e) * 3 + j) * 512 + ch] = xv; } } };
struct FE2 { PREF p; int e, r0;
    HD void operator()(long g) const { int row = r0 + (int)(g / 512), ch = (int)(g % 512), g8 = ch >> 6, jj = ch & 63; RowInfo ri = rowinfo(row);
        const float* xc = p.sA + (long)(row - r0) * 512 + g8 * 64; const float* wa = p.lru_wa + (long)((e * 8 + g8) * 64) * 64 + jj; const float* wx = p.lru_wx + (long)((e * 8 + g8) * 64) * 64 + jj;
        float rp = p.lru_ba[e * 512 + ch], ip = p.lru_bx[e * 512 + ch];
        for (int i = 0; i < 64; ++i) { rp += xc[i] * wa[i * 64]; ip += xc[i] * wx[i * 64]; }
        float r = sigmoidf_(rp), ii = sigmoidf_(ip), sp = log1pf(expf(-p.lru_lam[e * 512 + ch]));
        float la = -8.0f * r * sp, a = expf(la), mult = sqrtf(-expm1f(2.0f * la));
        if (!ri.sample && ri.t == 0) mult = 1.0f;
        p.sB[g] = a; p.sC[g] = mult * (ii * xc[jj]); } };
struct FE3 { PREF p; int e, r0, T, sample;
    HD void operator()(long g) const { int si = (int)(g / 512), ch = (int)(g % 512); int rowb = r0 + si * T;
        float h = sample ? p.state_lru_h[(long)(si * 2 + e) * 512 + ch] : 0.f;
        for (int t = 0; t < T; ++t) { long idx = (long)(rowb - r0 + t) * 512 + ch; h = p.sB[idx] * h + p.sC[idx];
            float ga = bf2f(p.PROJ[(long)(rowb + t) * NIN + 512 + ch]); p.Y[(long)(rowb + t) * DM + ch] = f2bf(h * geluf_(ga)); }
        int s = sample ? si : r0 / SEQ;
        p.out[(sample ? O_HS : O_HP) + (long)(s * 2 + e) * 512 + ch] = h; } };
struct FE4 { PREF p; int e, r0;
    HD void operator()(long g) const { int row = r0 + (int)(g / 512), ch = (int)(g % 512); RowInfo ri = rowinfo(row);
        float zb = 0.f, cur = 0.f;
        for (int j = 0; j < 3; ++j) { int tt = ri.t - 2 + j; float cx;
            if (tt >= 0) cx = bf2f(p.PROJ[(long)(ri.base + tt) * NIN + 1536 + ch]) * bf2f(p.PROJ[(long)(ri.base + tt) * NIN + 2048 + ch]);
            else cx = ri.sample ? p.state_sconv[((long)(ri.s * 2 + e) * 2 + (2 + tt)) * 512 + ch] : 0.f;
            zb += p.conv_b_w[(e * 3 + j) * 512 + ch] * cx; cur = cx; }
        p.Y[(long)row * DM + 512 + ch] = f2bf(bf2f(p.PROJ[(long)row * NIN + 1024 + ch]) * zb);
        if (ri.t >= ri.T - 2) p.out[(ri.sample ? O_SCS : O_SCP) + ((long)(ri.s * 2 + e) * 2 + (ri.t - (ri.T - 2))) * 512 + ch] = cur; } };

struct FO1 { PREF p; int r0, pad_;
    HD void operator()(long g) const { int row = r0 + (int)(g / 128), hh = (int)((g % 128) / 32), i = (int)(g % 32); RowInfo ri = rowinfo(row);
        int pi = ri.sample ? SEQ + ri.t : ri.t; float c = p.rope[(pi * 32 + i) * 2], s = p.rope[(pi * 32 + i) * 2 + 1];
        const bf16* pr = p.PROJ + (long)row * NIN; long o = (long)(row - r0) * 256 + hh * 64 + i;
        float q1 = bf2f(pr[hh * 64 + i]), q2 = bf2f(pr[hh * 64 + 32 + i]); p.sA[o] = q1 * c - q2 * s; p.sA[o + 32] = q1 * s + q2 * c;
        float k1 = bf2f(pr[256 + hh * 64 + i]), k2 = bf2f(pr[256 + hh * 64 + 32 + i]); p.sB[o] = 0.125f * (k1 * c - k2 * s); p.sB[o + 32] = 0.125f * (k1 * s + k2 * c); } };
struct FO2 { PREF p; int b, pad_;
    HD void operator()(long g) const { int e = (int)(g % 128), d = (int)((g / 128) % 64), hh = (int)((g / 8192) % 4), c = (int)(g / 32768);
        float acc = 0.f;
        for (int m = 0; m < 128; ++m) { int lr = c * 128 + m; acc += p.sB[(long)lr * 256 + hh * 64 + d] * gpow(hh, 127 - m) * bf2f(p.PROJ[(long)(b * SEQ + lr) * NIN + 512 + hh * 128 + e]); }
        p.sD[g] = acc; } };
struct FO3 { PREF p; int b, o;
    HD void operator()(long g) const { int hh = (int)(g / 8192); float S = 0.f, g128 = gpow(hh, 128);
        for (int c = 0; c < NC; ++c) { long i = (long)c * 32768 + g; p.sE[i] = S; S = g128 * S + p.sD[i]; }
        p.out[O_RP + (long)((b * 2 + o) * 4) * 8192 + g] = S; } };
struct FO4 { PREF p;
    HD void operator()(long g) const { int m = (int)(g % 128), l = (int)((g / 128) % 128), hh = (int)((g / 16384) % 4), c = (int)(g / 65536);
        float v = 0.f;
        if (m <= l) { const float* q = p.sA + (long)(c * 128 + l) * 256 + hh * 64; const float* k = p.sB + (long)(c * 128 + m) * 256 + hh * 64; float dot = 0.f; for (int d = 0; d < 64; ++d) dot += q[d] * k[d]; v = dot * gpow(hh, l - m); }
        p.sF[g] = v; } };
struct FO5 { PREF p; int b, pad_;
    HD void operator()(long g) const { int e = (int)(g % 128), l = (int)((g / 128) % 128), hh = (int)((g / 16384) % 4), c = (int)(g / 65536);
        const float* pm = p.sF + (long)(c * 4 + hh) * 16384 + l * 128; float acc = 0.f;
        for (int m = 0; m <= l; ++m) acc += pm[m] * bf2f(p.PROJ[(long)(b * SEQ + c * 128 + m) * NIN + 512 + hh * 128 + e]);
        const float* q = p.sA + (long)(c * 128 + l) * 256 + hh * 64; const float* s0 = p.sE + (long)(c * 4 + hh) * 8192 + e; float cr = 0.f; for (int d = 0; d < 64; ++d) cr += q[d] * s0[d * 128];
        p.sC[(long)(c * 128 + l) * 512 + hh * 128 + e] = acc + gpow(hh, l + 1) * cr; } };
struct FO5s { PREF p; int o, pad_;
    HD void operator()(long g) const { int e = (int)(g % 128), hh = (int)((g / 128) % 4), l = (int)((g / 512) % 4), n = (int)(g / 2048);
        const float* q = p.sA + (long)(n * 4 + l) * 256 + hh * 64; float acc = 0.f;
        for (int m = 0; m <= l; ++m) { const float* k = p.sB + (long)(n * 4 + m) * 256 + hh * 64; float dot = 0.f; for (int d = 0; d < 64; ++d) dot += q[d] * k[d];
            acc += gpow(hh, l - m) * dot * bf2f(p.PROJ[(long)(MP + n * 4 + m) * NIN + 512 + hh * 128 + e]); }
        const float* s0 = p.state_ret + (long)((n * 2 + o) * 4 + hh) * 8192 + e; float cr = 0.f; for (int d = 0; d < 64; ++d) cr += q[d] * s0[d * 128];
        p.sC[(long)(n * 4 + l) * 512 + hh * 128 + e] = acc + gpow(hh, l + 1) * cr; } };
struct FO3s { PREF p; int o, pad_;
    HD void operator()(long g) const { int e = (int)(g % 128), d = (int)((g / 128) % 64), hh = (int)((g / 8192) % 4), n = (int)(g / 32768);
        long si = (long)((n * 2 + o) * 4 + hh) * 8192 + d * 128 + e; float S = gpow(hh, 4) * p.state_ret[si];
        for (int l = 0; l < 4; ++l) S += gpow(hh, 3 - l) * p.sB[(long)(n * 4 + l) * 256 + hh * 64 + d] * bf2f(p.PROJ[(long)(MP + n * 4 + l) * NIN + 512 + hh * 128 + e]);
        p.out[O_RS + si] = S; } };
struct FO6 { PREF p; int o, r0;
    HD void operator()(long g) const { int row = r0 + (int)(g / 4), hh = (int)(g % 4); const float* ov = p.sC + (long)(row - r0) * 512 + hh * 128;
        float mu = 0.f; for (int e = 0; e < 128; ++e) mu += ov[e]; mu *= (1.0f / 128); float var = 0.f; for (int e = 0; e < 128; ++e) { float d = ov[e] - mu; var += d * d; } var *= (1.0f / 128);
        float rs = 1.0f / sqrtf(var + LN_EPS);
        for (int e = 0; e < 128; ++e) { float gt = bf2f(p.PROJ[(long)row * NIN + 1024 + hh * 128 + e]); p.Y[(long)row * DM + hh * 128 + e] = f2bf(siluf_(gt) * ((ov[e] - mu) * rs) * p.ret_gn_g[o * 512 + hh * 128 + e]); } } };
struct FO7 { PREF p; int o, r0;
    HD void operator()(long g) const { int row = r0 + (int)g; const bf16* pr = p.PROJ + (long)row * NIN + 2048; float* vd = p.sB + g * 512;
        float mu = 0.f; for (int c = 0; c < 512; ++c) { float v = geluf_(bf2f(pr[c])); vd[c] = v; mu += v; } mu *= (1.0f / 512);
        float var = 0.f; for (int c = 0; c < 512; ++c) { float d = vd[c] - mu; var += d * d; } var *= (1.0f / 512); float rs = 1.0f / sqrtf(var + LN_EPS);
        RowInfo ri = rowinfo(row);
        for (int c = 0; c < 512; ++c) { float v = (vd[c] - mu) * rs * p.gm_ln_g[o * 512 + c] + p.gm_ln_b[o * 512 + c]; vd[c] = v;
            if (ri.sample) p.out[O_CV + ((long)(ri.s * 2 + o) * 4 + ri.t) * 512 + c] = v; } } };
struct FO8 { PREF p; int o, r0;
    HD void operator()(long g) const { int row = r0 + (int)(g / 512), ch = (int)(g % 512), gg = ch >> 7; RowInfo ri = rowinfo(row);
        int tl = ri.sample ? ri.t : (ri.t & 127), cb = row - tl;
        float s = p.sp_b[(o * 4 + gg) * 128 + tl]; const float* w = p.sp_w + ((long)(o * 4 + gg) * 128 + tl) * 128;
        for (int s2 = 0; s2 <= tl; ++s2) s += w[s2] * p.sB[(long)(cb + s2 - r0) * 512 + ch];
        p.Y[(long)row * DM + 512 + ch] = f2bf(geluf_(bf2f(p.PROJ[(long)row * NIN + 1536 + ch])) * s); } };
namespace pg8 {
#define PG8_LAS __attribute__((address_space(3)))
typedef unsigned short bf16_t;
typedef short bf16x8 __attribute__((ext_vector_type(8)));
typedef float f32x4 __attribute__((ext_vector_type(4)));
typedef unsigned u32x4 __attribute__((ext_vector_type(4)));
constexpr int BM = 256, BK = 64, HALF = 128, HTB = HALF * BK * 2  , STAGE_BYTES = 8 * HTB, NXCD = 8, WGM = 8;

__host__ __device__ __forceinline__ int lds_byte(int r, int c) { const int st = (r >> 4) * 2 + (c >> 5), rr = r & 15, cc = c & 31, ob = rr * 64 + cc * 2; return st * 1024 + (ob ^ (((ob >> 9) & 1) << 5)); }
__host__ __device__ __forceinline__ void stage_rc(int b, int& R, int& C) { const int st = b / 1024, sb = b % 1024, swz = sb ^ (((sb >> 9) & 1) << 5); R = (st >> 1) * 16 + swz / 64; C = (st & 1) * 32 + (swz % 64) / 2; }
__host__ __device__ __forceinline__ int perm32(int rho) { const int n = rho >> 4, i = rho & 15; return 8 * (i >> 2) + 4 * n + (i & 3); }

struct Unit { int pm, pn; };
struct Gemm { const bf16_t* A; const bf16_t* Bt; int M, N, K; };

struct StaticOrder {
    int nM, nN, nwg, G, c;
    __host__ __device__ void init(int M, int N, int G_, int c_) { nM = M / BM; nN = N / BM; nwg = nM * nN; G = G_; c = c_; }
    __host__ __device__ bool next(int i, Unit& u) const {
        const long L = (long)i * G + c; if (L >= nwg) return false;
        int wgid = (int)L; { const int q = nwg / NXCD, r = nwg % NXCD, xcd = wgid % NXCD, off = wgid / NXCD; wgid = (xcd < r ? xcd * (q + 1) : r * (q + 1) + (xcd - r) * q) + off; }
        const int nig = WGM * nN, gid = wgid / nig, fm = gid * WGM, gsz = (nM - fm) < WGM ? (nM - fm) : WGM;
        u.pm = fm + ((wgid % nig) % gsz); u.pn = (wgid % nig) / gsz; return true;
    }
    __device__ __forceinline__ void a_ready(const Unit&) const {}
    __device__ __forceinline__ void done(const Unit&) const {}
};

__device__ __forceinline__ unsigned cvt_pk_bf16(float lo, float hi) { unsigned r; asm volatile("v_cvt_pk_bf16_f32 %0, %1, %2" : "=v"(r) : "v"(lo), "v"(hi)); return r; }
struct EpiProj {
    static constexpr bool PERM = true, AFTER_DRAIN = false;
    bf16_t* O; int ldc;
    __device__ __forceinline__ void operator()(const f32x4 (&acc)[2][2][4][2], const Unit& u, int wr, int wc, int fr, int fq) const {
        const int row0 = u.pm * BM + wr * 64 + fr, col0 = u.pn * BM + wc * 32 + 8 * fq;
#pragma unroll
        for (int ai = 0; ai < 2; ++ai)
#pragma unroll
            for (int m = 0; m < 4; ++m) { bf16_t* rowp = O + (size_t)(row0 + ai * HALF + m * 16) * ldc + col0;
#pragma unroll
                for (int bj = 0; bj < 2; ++bj) { const f32x4 v0 = acc[ai][bj][m][0], v1 = acc[ai][bj][m][1];
                    u32x4 w; w.x = cvt_pk_bf16(v0[0], v0[1]); w.y = cvt_pk_bf16(v0[2], v0[3]); w.z = cvt_pk_bf16(v1[0], v1[1]); w.w = cvt_pk_bf16(v1[2], v1[3]);
                    *(u32x4*)(rowp + bj * HALF) = w; } }
    }
};
__device__ __forceinline__ float silu_f(float x) { return x / (1.0f + __expf(-x)); }
struct EpiSwiglu {
    static constexpr bool PERM = true, AFTER_DRAIN = false;
    bf16_t* O; int ldc;
    __device__ __forceinline__ void operator()(const f32x4 (&acc)[2][2][4][2], const Unit& u, int wr, int wc, int fr, int fq) const {
        const int row0 = u.pm * BM + wr * 64 + fr, col0 = u.pn * HALF + wc * 32 + 8 * fq;
#pragma unroll
        for (int ai = 0; ai < 2; ++ai)
#pragma unroll
            for (int m = 0; m < 4; ++m) { bf16_t* rowp = O + (size_t)(row0 + ai * HALF + m * 16) * ldc + col0;
                float h[8];
#pragma unroll
                for (int n = 0; n < 2; ++n)
#pragma unroll
                    for (int i = 0; i < 4; ++i) h[n * 4 + i] = silu_f(acc[ai][0][m][n][i]) * acc[ai][1][m][n][i];
                u32x4 w; w.x = cvt_pk_bf16(h[0], h[1]); w.y = cvt_pk_bf16(h[2], h[3]); w.z = cvt_pk_bf16(h[4], h[5]); w.w = cvt_pk_bf16(h[6], h[7]);
                *(u32x4*)rowp = w; }
    }
};
struct EpiRes {
    static constexpr bool PERM = false, AFTER_DRAIN = false;
    float* X; int ldc; float alpha;
    __device__ __forceinline__ void operator()(const f32x4 (&acc)[2][2][4][2], const Unit& u, int wr, int wc, int fr, int fq) const {
        const int row0 = u.pm * BM + wr * 64 + fr, col0 = u.pn * BM + wc * 32 + 4 * fq;
#pragma unroll
        for (int ai = 0; ai < 2; ++ai)
#pragma unroll
            for (int m = 0; m < 4; ++m) { float* rowp = X + (size_t)(row0 + ai * HALF + m * 16) * ldc + col0;
#pragma unroll
                for (int bj = 0; bj < 2; ++bj)
#pragma unroll
                    for (int n = 0; n < 2; ++n) { f32x4* q = (f32x4*)(rowp + bj * HALF + n * 16); *q = *q * alpha + acc[ai][bj][m][n]; } }
    }
};
template <class Epi, class Sched, bool ALIGN_EPI = false, bool SP2 = false>
__device__ __forceinline__ void gemm_phase(PG8_LAS unsigned char* lds, const Gemm g, const Sched& S, const Epi& E) {
    int tid_ = threadIdx.x; asm volatile("" : "+v"(tid_)); const int tid = tid_, wid = __builtin_amdgcn_readfirstlane(tid >> 6), lane = tid & 63, wr = wid >> 2, wc = wid & 3, fr = lane & 15, fq = lane >> 4;
    const int K = g.K, nt = K / BK;
    unsigned voffA[2], voffB[2];
#pragma unroll
    for (int i = 0; i < 2; ++i) { int R, C; stage_rc(tid * 16 + i * 8192, R, C); const int Rb = Epi::PERM ? ((R & ~31) + perm32(R & 31)) : R;
        voffA[i] = (unsigned)(R * K + C) * 2u; voffB[i] = (unsigned)(Rb * K + C) * 2u; }
    const size_t kstep = (size_t)(BK * 2);
    const size_t hstep = (size_t)HALF * K * 2;
    const size_t tstep = 2 * hstep;
    const unsigned ldsw = (unsigned)wid * 1024u;
    const int aoff = lds_byte(wr * 64 + fr, fq * 8), boff = lds_byte(wc * 32 + fr, fq * 8);
#define PG8_SA(b, h) (((b) * 2 + (h)) * HTB)
#define PG8_SB(b, h) ((4 + (b) * 2 + (h)) * HTB)
#define PG8_STAGE(bufoff, gbase, voff) do { _Pragma("unroll") for (int _i = 0; _i < 2; ++_i) \
        __builtin_amdgcn_global_load_lds((const unsigned*)((const char*)(gbase) + (voff)[_i]), (PG8_LAS unsigned*)(lds + (bufoff) + ldsw + _i * 8192), 16, 0, 0); } while (0)
#define PG8_LDA(dst, b, h) do { _Pragma("unroll") for (int m = 0; m < 4; ++m) _Pragma("unroll") for (int k = 0; k < 2; ++k) dst[m][k] = *(const PG8_LAS bf16x8*)(lds + PG8_SA(b, h) + aoff + m * 2048 + k * 1024); } while (0)
#define PG8_LDB(dst, b, h) do { _Pragma("unroll") for (int n = 0; n < 2; ++n) _Pragma("unroll") for (int k = 0; k < 2; ++k) dst[n][k] = *(const PG8_LAS bf16x8*)(lds + PG8_SB(b, h) + boff + n * 2048 + k * 1024); } while (0)
#define PG8_MMA(ai, bj, At, Bt) do { __builtin_amdgcn_s_setprio(1); _Pragma("unroll") for (int m = 0; m < 4; ++m) _Pragma("unroll") for (int n = 0; n < 2; ++n) _Pragma("unroll") for (int k = 0; k < 2; ++k) \
        acc[ai][bj][m][n] = __builtin_amdgcn_mfma_f32_16x16x32_bf16(Bt[n][k], At[m][k], acc[ai][bj][m][n], 0, 0, 0); __builtin_amdgcn_s_setprio(0); } while (0)
#define PG8_WAIT_V(n) asm volatile("s_waitcnt vmcnt(" #n ")" ::: "memory")
#define PG8_WAIT_L(n) asm volatile("s_waitcnt lgkmcnt(" #n ")" ::: "memory")
#define PG8_BAR __builtin_amdgcn_s_barrier()
#define PG8_SCHED __builtin_amdgcn_sched_barrier(0)
    Unit cur, nxt; int ui = 0;
    if (!S.next(0, cur)) return;
    f32x4 acc[2][2][4][2];
#pragma unroll
    for (int a = 0; a < 2; ++a)
#pragma unroll
        for (int b = 0; b < 2; ++b)
#pragma unroll
            for (int m = 0; m < 4; ++m)
#pragma unroll
                for (int n = 0; n < 2; ++n) acc[a][b][m][n] = (f32x4){0.f, 0.f, 0.f, 0.f};
    bf16x8 At[4][2], B0[2][2], B1[2][2];
    const char* cA = (const char*)g.A + (size_t)cur.pm * tstep; const char* cB = (const char*)g.Bt + (size_t)cur.pn * tstep;
    S.a_ready(cur);
    if constexpr (SP2) {
        PG8_STAGE(PG8_SB(0, 0), cB, voffB); PG8_STAGE(PG8_SB(0, 1), cB + hstep, voffB); PG8_STAGE(PG8_SA(0, 0), cA, voffA); PG8_STAGE(PG8_SA(0, 1), cA + hstep, voffA);
        if (wr == 1) PG8_BAR;
        PG8_WAIT_V(2); PG8_BAR;
        PG8_STAGE(PG8_SB(1, 0), cB + kstep, voffB); PG8_STAGE(PG8_SA(1, 0), cA + kstep, voffA); PG8_STAGE(PG8_SB(1, 1), cB + hstep + kstep, voffB);
        PG8_WAIT_V(6); PG8_BAR;
    } else {
        PG8_STAGE(PG8_SB(0, 0), cB, voffB); PG8_STAGE(PG8_SA(0, 0), cA, voffA); PG8_STAGE(PG8_SB(0, 1), cB + hstep, voffB); PG8_STAGE(PG8_SA(0, 1), cA + hstep, voffA);
        if (wr == 1) PG8_BAR;
        PG8_WAIT_V(4); PG8_BAR;
        PG8_STAGE(PG8_SB(1, 0), cB + kstep, voffB); PG8_STAGE(PG8_SA(1, 0), cA + kstep, voffA); PG8_STAGE(PG8_SB(1, 1), cB + hstep + kstep, voffB);
        PG8_WAIT_V(6); PG8_BAR;
    }
    for (;;) {
        const bool has_next = S.next(ui + 1, nxt);
        const char* nA = has_next ? (const char*)g.A + (size_t)nxt.pm * tstep : cA; const char* nB = has_next ? (const char*)g.Bt + (size_t)nxt.pn * tstep : cB;
        for (int t = 0; t < nt; t += 2) {
            const bool last = (t == nt - 2);
            const char* a1 = cA + (size_t)(t + 1) * kstep;
            const char* a2 = last ? nA : cA + (size_t)(t + 2) * kstep; const char* b2 = last ? nB : cB + (size_t)(t + 2) * kstep;
            const char* a3 = a2 + kstep; const char* b3 = b2 + kstep;
            if (last && has_next) S.a_ready(nxt);
            if constexpr (SP2) {
            PG8_LDB(B0, 0, 0); PG8_LDB(B1, 0, 1); PG8_SCHED; PG8_LDA(At, 0, 0); PG8_STAGE(PG8_SA(1, 1), a1 + hstep, voffA);
            PG8_WAIT_V(8); PG8_WAIT_L(0); PG8_BAR; PG8_MMA(0, 0, At, B0); PG8_MMA(0, 1, At, B1); PG8_BAR; PG8_SCHED;
            PG8_LDA(At, 0, 1); PG8_STAGE(PG8_SB(0, 0), b2, voffB); PG8_STAGE(PG8_SB(0, 1), b2 + hstep, voffB); PG8_STAGE(PG8_SA(0, 0), a2, voffA);
            PG8_WAIT_V(8); PG8_WAIT_L(0); PG8_BAR; PG8_MMA(1, 0, At, B0); PG8_MMA(1, 1, At, B1); PG8_BAR; PG8_SCHED;
            PG8_LDB(B0, 1, 0); PG8_LDB(B1, 1, 1); PG8_SCHED; PG8_LDA(At, 1, 0); PG8_STAGE(PG8_SA(0, 1), a2 + hstep, voffA);
            PG8_WAIT_V(8); PG8_WAIT_L(0); PG8_BAR; PG8_MMA(0, 0, At, B0); PG8_MMA(0, 1, At, B1); PG8_BAR; PG8_SCHED;
            PG8_LDA(At, 1, 1); PG8_STAGE(PG8_SB(1, 0), b3, voffB); PG8_STAGE(PG8_SB(1, 1), b3 + hstep, voffB); PG8_STAGE(PG8_SA(1, 0), a3, voffA);
            PG8_WAIT_V(8); PG8_WAIT_L(0); PG8_BAR; PG8_MMA(1, 0, At, B0); PG8_MMA(1, 1, At, B1); PG8_BAR; PG8_SCHED;
            } else {
            PG8_LDB(B0, 0, 0); PG8_SCHED; PG8_LDA(At, 0, 0); PG8_STAGE(PG8_SA(1, 1), a1 + hstep, voffA);
            PG8_WAIT_L(8); PG8_BAR; PG8_WAIT_L(0); PG8_MMA(0, 0, At, B0); PG8_BAR; PG8_SCHED;
            PG8_LDB(B1, 0, 1); PG8_STAGE(PG8_SB(0, 0), b2, voffB);
            PG8_BAR; PG8_WAIT_L(0); PG8_MMA(0, 1, At, B1); PG8_BAR;
            PG8_LDA(At, 0, 1); PG8_STAGE(PG8_SA(0, 0), a2, voffA);
            PG8_BAR; PG8_WAIT_L(0); PG8_MMA(1, 0, At, B0); PG8_BAR; PG8_SCHED;
            PG8_STAGE(PG8_SB(0, 1), b2 + hstep, voffB);
            PG8_WAIT_V(6); PG8_BAR; PG8_MMA(1, 1, At, B1); PG8_BAR;
            PG8_LDB(B0, 1, 0); PG8_SCHED; PG8_LDA(At, 1, 0); PG8_STAGE(PG8_SA(0, 1), a2 + hstep, voffA);
            PG8_WAIT_L(8); PG8_BAR; PG8_WAIT_L(0); PG8_MMA(0, 0, At, B0); PG8_BAR; PG8_SCHED;
            PG8_LDB(B1, 1, 1); PG8_STAGE(PG8_SB(1, 0), b3, voffB);
            PG8_BAR; PG8_WAIT_L(0); PG8_MMA(0, 1, At, B1); PG8_BAR;
            PG8_LDA(At, 1, 1); PG8_STAGE(PG8_SA(1, 0), a3, voffA);
            PG8_BAR; PG8_WAIT_L(0); PG8_MMA(1, 0, At, B0); PG8_BAR; PG8_SCHED;
            PG8_STAGE(PG8_SB(1, 1), b3 + hstep, voffB);
            PG8_WAIT_V(6); PG8_BAR; PG8_MMA(1, 1, At, B1); PG8_BAR;
            }
        }
        if constexpr (ALIGN_EPI) { if (wr == 0) PG8_BAR; }
        if constexpr (!Epi::AFTER_DRAIN) { E(acc, cur, wr, wc, fr, fq); S.done(cur); }
        if (!has_next) break;
#pragma unroll
        for (int a = 0; a < 2; ++a)
#pragma unroll
            for (int b = 0; b < 2; ++b)
#pragma unroll
                for (int m = 0; m < 4; ++m)
#pragma unroll
                    for (int n = 0; n < 2; ++n) acc[a][b][m][n] = (f32x4){0.f, 0.f, 0.f, 0.f};
        cur = nxt; cA = nA; cB = nB; ++ui;
        if constexpr (ALIGN_EPI) { if (wr == 1) PG8_BAR; }
    }
    PG8_WAIT_V(0);
    if constexpr (!ALIGN_EPI) { if (wr == 0) PG8_BAR; }
    PG8_BAR;
    if constexpr (Epi::AFTER_DRAIN) { E.fused(acc, cur, wr, wc, fr, fq, lds, wid, lane); S.done(cur); }
#undef PG8_SA
#undef PG8_SB
#undef PG8_STAGE
#undef PG8_LDA
#undef PG8_LDB
#undef PG8_MMA
#undef PG8_WAIT_V
#undef PG8_WAIT_L
#undef PG8_BAR
#undef PG8_SCHED
}
}
#include <hip/hip_cooperative_groups.h>
namespace cg = cooperative_groups;
#define LAS __attribute__((address_space(3)))
typedef float f32x4 __attribute__((ext_vector_type(4)));
typedef unsigned u32x2 __attribute__((ext_vector_type(2)));
typedef unsigned u32x4 __attribute__((ext_vector_type(4)));
typedef short bf16x8 __attribute__((ext_vector_type(8)));
constexpr int NTHR = 512, NWAVES = 8, LDS_BYTES = 147456;
#define LDS_WAIT() asm volatile("s_waitcnt lgkmcnt(0)" ::: "memory")
__device__ __forceinline__ unsigned pk2(float lo, float hi) { return pg8::cvt_pk_bf16(lo, hi); }
__device__ __forceinline__ float wave_sum(float v) {
#pragma unroll
    for (int o = 1; o < 64; o <<= 1) v += __shfl_xor(v, o);
    return v;
}
struct Ctx { LAS unsigned char* lds; int tid, lane, wave, gw, ngw; };
__device__ __forceinline__ Ctx mkctx(LAS unsigned char* lds) { Ctx c; c.lds = lds; int t = threadIdx.x; asm volatile("" : "+v"(t)); c.tid = t; c.lane = t & 63; c.wave = __builtin_amdgcn_readfirstlane(t >> 6);
    c.gw = (int)blockIdx.x * NWAVES + c.wave; c.ngw = (int)gridDim.x * NWAVES; return c; }
__device__ __forceinline__ PREF kparams() { const CONSTAS P* q = (const CONSTAS P*)__builtin_amdgcn_kernarg_segment_ptr(); asm volatile("" : "+s"(q)); return *q; }
constexpr int MISC_OFF = 131072;
#define XB_TMO      128
#define XB_XCNT(j)  (256  + 64 * (j))
#define XB_XSUB(j)  (1280 + 64 * (j))
#define XB_XGEN(j)  (2304 + 64 * (j))
#define XB_TOP      3328
#define XB_TOPGEN   3392
#define XCD_BAR_WORDS 3456
#define XB_SPIN_CAP (1u << 18)

__device__ __forceinline__ unsigned xb_ld(unsigned* p)              { return __hip_atomic_load(p, __ATOMIC_RELAXED, __HIP_MEMORY_SCOPE_AGENT); }
__device__ __forceinline__ unsigned xb_add(unsigned* p, unsigned v) { return __hip_atomic_fetch_add(p, v, __ATOMIC_RELAXED, __HIP_MEMORY_SCOPE_AGENT); }
__device__ __forceinline__ unsigned xb_xcc_id() { return (unsigned)__builtin_amdgcn_s_getreg((3 << 11) | 20) & 0xFu; }
#define XB_SPIN(cond, bar) do { unsigned _sp = 0; while (cond) { __builtin_amdgcn_s_sleep(1); \
    if ((++_sp & 255u) == 0u) { if (xb_ld(&(bar)[XB_TMO])) break; if (_sp > XB_SPIN_CAP) { atomicAdd(&(bar)[XB_TMO], 1u); break; } } } } while (0)

struct XcdBarrier {
    unsigned* bar; unsigned x;
    volatile LAS unsigned* st;
};

__device__ __forceinline__ XcdBarrier xcd_barrier_post(unsigned* bar, volatile LAS unsigned* st) {
    XcdBarrier b; b.bar = bar; b.x = xb_xcc_id(); b.st = st;
    if (threadIdx.x == 0) (void)xb_add(&bar[XB_XCNT(b.x)], 1u);
    return b;
}
__device__ __forceinline__ void xcd_barrier_complete(unsigned* bar, unsigned x, unsigned& nloc, unsigned& nx) {
    const unsigned G = gridDim.x * gridDim.y * gridDim.z;
    unsigned sum, cnt, mine, sp = 0u;
    for (;;) {
        sum = 0u; cnt = 0u; mine = 0u;
#pragma unroll
        for (unsigned j = 0; j < 16; ++j) { const unsigned c = xb_ld(&bar[XB_XCNT(j)]); sum += c; cnt += (c > 0u) ? 1u : 0u; mine = (j == x) ? c : mine; }
        if (sum == G) break;
        __builtin_amdgcn_s_sleep(1);
        if ((++sp & 255u) == 0u) { if (xb_ld(&bar[XB_TMO])) break; if (sp > XB_SPIN_CAP) { atomicAdd(&bar[XB_TMO], 1u); break; } }
    }
    nloc = mine > 0u ? mine : 1u; nx = cnt > 0u ? cnt : 1u;
}

__device__ __forceinline__ void xcd_barrier(const XcdBarrier& b) {
    asm volatile("s_waitcnt vmcnt(0)" ::: "memory");
    __syncthreads();
    if (threadIdx.x == 0) {
        unsigned* bar = b.bar;
        __builtin_amdgcn_s_waitcnt(0);
        unsigned nloc = b.st[0], nx = b.st[1];
        if (nloc == 0u) { xcd_barrier_complete(bar, b.x, nloc, nx); b.st[0] = nloc; b.st[1] = nx; }
        const unsigned old = xb_add(&bar[XB_XSUB(b.x)], 1u);
        const unsigned gen = old / nloc;
        if (old + 1u == (gen + 1u) * nloc) {
            __builtin_amdgcn_fence(__ATOMIC_RELEASE, "agent");
            asm volatile("s_waitcnt vmcnt(0)" ::: "memory");
            const unsigned og = xb_add(&bar[XB_TOP], 1u);
            const unsigned tg = og / nx;
            if (og + 1u == (tg + 1u) * nx) xb_add(&bar[XB_TOPGEN], 1u);
            else XB_SPIN(xb_ld(&bar[XB_TOPGEN]) == tg, bar);
            __builtin_amdgcn_fence(__ATOMIC_ACQUIRE, "agent");
            xb_add(&bar[XB_XGEN(b.x)], 1u);
            asm volatile("s_waitcnt vmcnt(0)" ::: "memory");
        } else {
            XB_SPIN(xb_ld(&bar[XB_XGEN(b.x)]) == gen, bar);
            __builtin_amdgcn_fence(__ATOMIC_ACQUIRE, "agent");
            asm volatile("s_waitcnt vmcnt(0)" ::: "memory");
        }
    }
    __syncthreads();
}
__device__ __forceinline__ void grid_barrier(LAS unsigned char* lds) {
    XcdBarrier b; b.bar = (unsigned*)(kparams().ws + WS_CTL); b.x = xb_xcc_id(); b.st = (volatile LAS unsigned*)(lds + MISC_OFF) + 8;
    xcd_barrier(b);
}
#define GRID_SYNC() grid_barrier(lds)

template <class F> __device__ __forceinline__ void run_simple(F f, long n) {
    int tid = threadIdx.x; asm volatile("" : "+v"(tid));
    for (long g = (long)blockIdx.x * NTHR + tid; g < n; g += (long)gridDim.x * NTHR) f(g);
}

__device__ __forceinline__ void transpose_item(const float* W, int N, bf16* WT, int Kd, int k0, int n0, int drow0, LAS float* scr, int lane) {
#pragma unroll 8
    for (int i = 0; i < 32; ++i) { const int kk = 2 * i + (lane >> 5); scr[kk * 33 + (lane & 31)] = W[(size_t)(k0 + kk) * N + n0 + (lane & 31)]; }
    LDS_WAIT();
    const int c = lane & 7;
#pragma unroll
    for (int j = 0; j < 4; ++j) { const int n = (lane >> 3) + 8 * j; const LAS float* s = scr + (8 * c) * 33 + n;
        u32x4 o; o.x = pk2(s[0 * 33], s[1 * 33]); o.y = pk2(s[2 * 33], s[3 * 33]); o.z = pk2(s[4 * 33], s[5 * 33]); o.w = pk2(s[6 * 33], s[7 * 33]);
        *(u32x4*)(WT + (size_t)(drow0 + n) * Kd + k0 + 8 * c) = o; }
    LDS_WAIT();
}
__device__ __forceinline__ void phase_prep(const Ctx& c) {
    PREF p = kparams();
    LAS float* scr = (LAS float*)(c.lds + c.wave * 16384);
    constexpr int I_IN = (DM / 64) * (NIN / 32), I_OUT = (DM / 64) * (DM / 32), I_F = (DM / 64) * (DFF / 32), I_2 = (DFF / 64) * (DM / 32), I_L = I_IN + I_OUT + 2 * I_F + I_2;
    for (int it = c.gw; it < DEPTH * I_L; it += c.ngw) {
        const int l = it / I_L; int r = it % I_L;
        if (r < I_IN) { const float* W = (l % 2 == 0 ? p.w_in_even : p.w_in_odd) + (size_t)(l / 2) * DM * NIN; const int nb = NIN / 32;
            transpose_item(W, NIN, p.Wt_in + (size_t)l * NIN * DM, DM, 64 * (r / nb), 32 * (r % nb), 32 * (r % nb), scr, c.lane); continue; } r -= I_IN;
        if (r < I_OUT) { const float* W = (l % 2 == 0 ? p.w_out_even : p.w_out_odd) + (size_t)(l / 2) * DM * DM; const int nb = DM / 32;
            transpose_item(W, DM, p.Wt_out + (size_t)l * DM * DM, DM, 64 * (r / nb), 32 * (r % nb), 32 * (r % nb), scr, c.lane); continue; } r -= I_OUT;
        if (r < 2 * I_F) { const int half = r >= I_F; if (half) r -= I_F; const float* W = (half ? p.ffn_w3 : p.ffn_w1) + (size_t)l * DM * DFF; const int nb = DFF / 32, n0 = 32 * (r % nb);
            transpose_item(W, DFF, p.Wt_13 + (size_t)l * 2 * DFF * DM, DM, 64 * (r / nb), n0, (n0 >> 7) * 256 + half * 128 + (n0 & 127), scr, c.lane); continue; } r -= 2 * I_F;
        { const float* W = p.ffn_w2 + (size_t)l * DFF * DM; const int nb = DM / 32;
            transpose_item(W, DM, p.Wt_2 + (size_t)l * DM * DFF, DFF, 64 * (r / nb), 32 * (r % nb), 32 * (r % nb), scr, c.lane); }
    }
    for (long i = (long)blockIdx.x * NTHR + c.tid; i < (long)M * DM / 4; i += (long)gridDim.x * NTHR) {
        const f32x4 v = i < (long)MP * DM / 4 ? ((const f32x4*)p.x_prompt)[i] : ((const f32x4*)p.x_sample)[i - (long)MP * DM / 4];
        ((f32x4*)p.XF)[i] = v; u32x2 w; w.x = pk2(v.x, v.y); w.y = pk2(v.z, v.w); ((u32x2*)p.XB)[i] = w; }
    run_simple(FRope{p.rope}, (long)(SEQ + 4) * 32);
    for (int i = (int)blockIdx.x * NTHR + c.tid; i < 2 * 8 * 64 * 64; i += (int)gridDim.x * NTHR) { const int eg = i >> 12, j = (i >> 6) & 63, ii = i & 63;
        p.WaT[i] = f2bf(p.lru_wa[eg * 4096 + ii * 64 + j]); p.WxT[i] = f2bf(p.lru_wx[eg * 4096 + ii * 64 + j]); }
    for (int i = (int)blockIdx.x * NTHR + c.tid; i < 2 * 4 * 128 * 128; i += (int)gridDim.x * NTHR) { const int t = (i >> 7) & 127, s2 = i & 127; p.Wtril[i] = s2 <= t ? f2bf(p.sp_w[i]) : (bf16)0; }
}

__device__ __forceinline__ void phase_ln(const Ctx& c, const float* g, const float* b) {
    PREF p = kparams();
    f32x4 gv[4], bv[4];
#pragma unroll
    for (int j = 0; j < 4; ++j) { gv[j] = ((const f32x4*)g)[c.lane + 64 * j]; bv[j] = ((const f32x4*)b)[c.lane + 64 * j]; }
    for (int row = c.gw; row < M; row += c.ngw) {
        f32x4* xr = (f32x4*)(p.XF + (size_t)row * DM) + c.lane; f32x4 v[4]; float s = 0.f;
#pragma unroll
        for (int j = 0; j < 4; ++j) { v[j] = xr[64 * j]; s += (v[j].x + v[j].y) + (v[j].z + v[j].w); }
        const float mean = wave_sum(s) * (1.f / DM); float s2 = 0.f;
#pragma unroll
        for (int j = 0; j < 4; ++j) { v[j] = v[j] - mean; s2 += (v[j].x * v[j].x + v[j].y * v[j].y) + (v[j].z * v[j].z + v[j].w * v[j].w); }
        const float rstd = 1.f / sqrtf(wave_sum(s2) * (1.f / DM) + LN_EPS);
        u32x2* o8 = (u32x2*)(p.XB + (size_t)row * DM) + c.lane;
#pragma unroll
        for (int j = 0; j < 4; ++j) { const f32x4 o = v[j] * rstd * gv[j] + bv[j]; xr[64 * j] = o; u32x2 w; w.x = pk2(o.x, o.y); w.y = pk2(o.z, o.w); o8[64 * j] = w; }
    }
}

template <class Epi> __device__ __forceinline__ void phase_gemm(const Ctx& c, const bf16* A, const bf16* Bt, int Mrows, int N, int K, Epi E) {
    pg8::Gemm g{A, Bt, Mrows, N, K}; pg8::StaticOrder S; S.init(Mrows, N, (int)gridDim.x, (int)blockIdx.x);
    pg8::gemm_phase<Epi, pg8::StaticOrder, true, true>(c.lds, g, S, E);
}

__device__ __forceinline__ void sample_gemm_tail(const Ctx& c, const bf16* A, const bf16* Bt, int K, float* X, float alpha) {
    constexpr int NU = (MS / 32) * (DM / 64);
    int tid_ = c.tid; asm volatile("" : "+v"(tid_));
    const int lane = tid_ & 63, q = lane >> 4, r16 = lane & 15, w = c.wave;
    for (int u = (int)blockIdx.x; u < NU; u += (int)gridDim.x) {
        const int um = u / (DM / 64), un = u % (DM / 64), kw = K / 8, nks = kw / 32, ng = (nks + 2) / 3;
        const bf16* ap = A + (size_t)(MP + 32 * um + r16) * K + w * kw + 8 * q; const bf16* bp = Bt + (size_t)(64 * un + r16) * K + w * kw + 8 * q;
        f32x4 acc[2][4];
#pragma unroll
        for (int i = 0; i < 2; ++i)
#pragma unroll
            for (int j = 0; j < 4; ++j) acc[i][j] = (f32x4){0.f, 0.f, 0.f, 0.f};
        bf16x8 fa0[3][2], fb0[3][4], fa1[3][2], fb1[3][4];
#define SG_LOAD(fa, fb, g) do { _Pragma("unroll") for (int s = 0; s < 3; ++s) if ((g) * 3 + s < nks) { \
            _Pragma("unroll") for (int i = 0; i < 2; ++i) fa[s][i] = *(const bf16x8*)(ap + (size_t)(16 * i) * K + ((g) * 3 + s) * 32); \
            _Pragma("unroll") for (int j = 0; j < 4; ++j) fb[s][j] = *(const bf16x8*)(bp + (size_t)(16 * j) * K + ((g) * 3 + s) * 32); } } while (0)
#define SG_MMA(fa, fb, g) do { _Pragma("unroll") for (int s = 0; s < 3; ++s) if ((g) * 3 + s < nks) { \
            _Pragma("unroll") for (int i = 0; i < 2; ++i) _Pragma("unroll") for (int j = 0; j < 4; ++j) acc[i][j] = __builtin_amdgcn_mfma_f32_16x16x32_bf16(fb[s][j], fa[s][i], acc[i][j], 0, 0, 0); } } while (0)
        SG_LOAD(fa0, fb0, 0);
        for (int g = 0; g < ng; g += 2) {
            if (g + 1 < ng) SG_LOAD(fa1, fb1, g + 1);
            SG_MMA(fa0, fb0, g);
            if (g + 2 < ng) SG_LOAD(fa0, fb0, g + 2);
            if (g + 1 < ng) SG_MMA(fa1, fb1, g + 1);
        }
#undef SG_LOAD
#undef SG_MMA
        LAS float* Pw = (LAS float*)c.lds + w * 2048;
#pragma unroll
        for (int i = 0; i < 2; ++i)
#pragma unroll
            for (int j = 0; j < 4; ++j) *(LAS f32x4*)(Pw + (16 * i + r16) * 64 + 16 * j + 4 * q) = acc[i][j];
        __syncthreads();
        { const int m = tid_ >> 4, n4 = (tid_ & 15) * 4; f32x4 s0 = {0.f, 0.f, 0.f, 0.f};
#pragma unroll
          for (int ww = 0; ww < 8; ++ww) s0 += *(const LAS f32x4*)((LAS float*)c.lds + ww * 2048 + m * 64 + n4);
          f32x4* xp = (f32x4*)(X + (size_t)(MP + 32 * um + m) * DM + 64 * un + n4); xp[0] = xp[0] * alpha + s0; }
        __syncthreads();
    }
}

#define FAST_EVEN 1
#define FAST_ODD 1
constexpr int LCH = 64, NCH = SEQ / LCH;
constexpr int N_PBU = (BATCH * NCH / 8) * 8, N_SBU = (MS / 16 / 8) * 8;
constexpr int LRU_W_BYTES = 2 * 64 * 72 * 2, LRU_LDS_WAVE = 11264;
__device__ __forceinline__ float gelu_fast(float x) { const float u = 0.7978845608028654f * (x + 0.044715f * x * x * x); return x / (1.0f + __expf(-2.0f * u)); }
__device__ __forceinline__ float silu_fast(float x) { return x / (1.0f + __expf(-x)); }
__device__ __forceinline__ float sigmoid_fast(float x) { return 1.0f / (1.0f + __expf(-x)); }
template <int MODE> __device__ __forceinline__ void lru_unit(const Ctx& c, PREF p, int e, int sample, int row0, int b, int ch64, int g, int nsb) {
    int lane_ = c.lane; asm volatile("" : "+v"(lane_));
    const int lane = lane_, ch = g * 64 + lane, q = lane >> 4, r16 = lane & 15;
    const LAS bf16* WA = (const LAS bf16*)c.lds; const LAS bf16* WX = WA + 64 * 72;
    LAS unsigned char* wl = c.lds + LRU_W_BYTES + c.wave * LRU_LDS_WAVE;
    LAS bf16* XT = (LAS bf16*)wl; LAS float* GR = (LAS float*)(wl + 2304); LAS float* GI = (LAS float*)(wl + 2304 + 4352);
    const float cw0 = p.conv_a_w[(e * 4 + 0) * 512 + ch], cw1 = p.conv_a_w[(e * 4 + 1) * 512 + ch], cw2 = p.conv_a_w[(e * 4 + 2) * 512 + ch], cw3 = p.conv_a_w[(e * 4 + 3) * 512 + ch];
    const float cb = p.conv_a_b[e * 512 + ch], ba = p.lru_ba[e * 512 + ch], bx = p.lru_bx[e * 512 + ch], sp8 = -8.0f * log1pf(expf(-p.lru_lam[e * 512 + ch]));
    float wb0 = 0.f, wb1 = 0.f, wb2 = 0.f;
    if (MODE == 1) { wb0 = p.conv_b_w[(e * 3 + 0) * 512 + ch]; wb1 = p.conv_b_w[(e * 3 + 1) * 512 + ch]; wb2 = p.conv_b_w[(e * 3 + 2) * 512 + ch]; }
    float h = 0.f, aprod = 1.f, x1 = 0.f, x2 = 0.f, x3 = 0.f, c1 = 0.f, c2 = 0.f;
    const bf16* pr0 = p.PROJ + (size_t)row0 * NIN + ch;
    if (!sample && ch64 > 0) {
        x1 = bf2f(pr0[-1 * NIN]); x2 = bf2f(pr0[-2 * NIN]); x3 = bf2f(pr0[-3 * NIN]);
        if (MODE == 1) { c1 = bf2f(pr0[-1 * NIN + 1536]) * bf2f(pr0[-1 * NIN + 2048]); c2 = bf2f(pr0[-2 * NIN + 1536]) * bf2f(pr0[-2 * NIN + 2048]);
            const float* ap = p.AP + (size_t)b * NCH * 512 + ch; const float* he = p.HE + (size_t)b * NCH * 512 + ch;
            for (int j0 = 0; j0 < ch64; j0 += 8) { float av[8], hv[8];
#pragma unroll
                for (int i = 0; i < 8; ++i) { const int jj = j0 + i < ch64 ? j0 + i : ch64 - 1; av[i] = ap[jj * 512]; hv[i] = he[jj * 512]; }
#pragma unroll
                for (int i = 0; i < 8; ++i) if (j0 + i < ch64) h = av[i] * h + hv[i]; } }
    }
    for (int sb = 0; sb < nsb; ++sb) {
        const int rb = row0 + 16 * sb; const bf16* pr = p.PROJ + (size_t)rb * NIN + ch;
        float xc[16], ga[16], bg[16], cx[16];
        { float xa[16];
#pragma unroll
          for (int t = 0; t < 16; ++t) xa[t] = bf2f(pr[t * NIN]);
          if (MODE == 1) {
#pragma unroll
              for (int t = 0; t < 16; ++t) { ga[t] = bf2f(pr[t * NIN + 512]); bg[t] = bf2f(pr[t * NIN + 1024]); cx[t] = bf2f(pr[t * NIN + 1536]) * bf2f(pr[t * NIN + 2048]); }
          }
          float stc[4][3];
          if (sample) {
#pragma unroll
              for (int s4 = 0; s4 < 4; ++s4) { const float* st = p.state_lru_conv + (size_t)(((((rb - MP) >> 2) + s4) * 2 + e) * 3) * 512 + ch; stc[s4][0] = st[0]; stc[s4][1] = st[512]; stc[s4][2] = st[1024]; }
          }
#pragma unroll
          for (int t = 0; t < 16; ++t) {
              if (sample && (t & 3) == 0) { x3 = stc[t >> 2][0]; x2 = stc[t >> 2][1]; x1 = stc[t >> 2][2]; }
              xc[t] = cb + cw0 * x3 + cw1 * x2 + cw2 * x1 + cw3 * xa[t]; x3 = x2; x2 = x1; x1 = xa[t];
              XT[t * 72 + lane] = f2bf(xc[t]);
          } }
        LDS_WAIT();
        { const bf16x8 y0 = *(const LAS bf16x8*)(XT + r16 * 72 + 8 * q), y1 = *(const LAS bf16x8*)(XT + r16 * 72 + 32 + 8 * q);
#pragma unroll
          for (int nt = 0; nt < 4; ++nt) { f32x4 ar = {0.f, 0.f, 0.f, 0.f}, ai = {0.f, 0.f, 0.f, 0.f};
              ar = __builtin_amdgcn_mfma_f32_16x16x32_bf16(*(const LAS bf16x8*)(WA + (16 * nt + r16) * 72 + 8 * q), y0, ar, 0, 0, 0);
              ar = __builtin_amdgcn_mfma_f32_16x16x32_bf16(*(const LAS bf16x8*)(WA + (16 * nt + r16) * 72 + 32 + 8 * q), y1, ar, 0, 0, 0);
              ai = __builtin_amdgcn_mfma_f32_16x16x32_bf16(*(const LAS bf16x8*)(WX + (16 * nt + r16) * 72 + 8 * q), y0, ai, 0, 0, 0);
              ai = __builtin_amdgcn_mfma_f32_16x16x32_bf16(*(const LAS bf16x8*)(WX + (16 * nt + r16) * 72 + 32 + 8 * q), y1, ai, 0, 0, 0);
              *(LAS f32x4*)(GR + r16 * 68 + 16 * nt + 4 * q) = ar; *(LAS f32x4*)(GI + r16 * 68 + 16 * nt + 4 * q) = ai; } }
        LDS_WAIT();
        float sth[4], sts[4][2];
        if (MODE == 1 && sample) {
#pragma unroll
            for (int s4 = 0; s4 < 4; ++s4) { const int n = ((rb - MP) >> 2) + s4; sth[s4] = p.state_lru_h[(size_t)(n * 2 + e) * 512 + ch];
                const float* s2 = p.state_sconv + (size_t)((n * 2 + e) * 2) * 512 + ch; sts[s4][0] = s2[0]; sts[s4][1] = s2[512]; }
        }
#pragma unroll
        for (int t = 0; t < 16; ++t) {
            const float rg = sigmoid_fast(GR[t * 68 + lane] + ba), ig = sigmoid_fast(GI[t * 68 + lane] + bx);
            const float la = sp8 * rg, a = __expf(la), x2a = 2.0f * la;
            const float m2 = x2a > -0.25f ? -x2a * (1.0f + x2a * (0.5f + x2a * (0.16666667f + x2a * (0.041666668f + x2a * (0.0083333338f + x2a * 0.0013888889f))))) : 1.0f - __expf(x2a);
            float mult = sqrtf(m2);
            if (!sample && ch64 == 0 && sb == 0 && t == 0) mult = 1.0f;
            if (MODE == 1 && sample && (t & 3) == 0) h = sth[t >> 2];
            h = a * h + mult * (ig * xc[t]); aprod *= a;
            if (MODE == 1) {
                const int n = (rb + t - MP) >> 2;
                bf16* yr = p.Y + (size_t)(rb + t) * DM + ch;
                yr[0] = f2bf(h * gelu_fast(ga[t]));
                if (sample && (t & 3) == 0) { c2 = sts[t >> 2][0]; c1 = sts[t >> 2][1]; }
                yr[512] = f2bf(bg[t] * (wb0 * c2 + wb1 * c1 + wb2 * cx[t])); c2 = c1; c1 = cx[t];
                if (sample) { const int tt = t & 3;
                    if (tt >= 1) p.out[O_CAS + ((size_t)(n * 2 + e) * 3 + (tt - 1)) * 512 + ch] = bf2f(pr[t * NIN]);
                    if (tt >= 2) p.out[O_SCS + ((size_t)(n * 2 + e) * 2 + (tt - 2)) * 512 + ch] = cx[t];
                    if (tt == 3) p.out[O_HS + (size_t)(n * 2 + e) * 512 + ch] = h;
                } else if (ch64 == NCH - 1 && sb == LCH / 16 - 1) {
                    if (t >= 13) p.out[O_CAP + ((size_t)(b * 2 + e) * 3 + (t - 13)) * 512 + ch] = bf2f(pr[t * NIN]);
                    if (t >= 14) p.out[O_SCP + ((size_t)(b * 2 + e) * 2 + (t - 14)) * 512 + ch] = cx[t];
                    if (t == 15) p.out[O_HP + (size_t)(b * 2 + e) * 512 + ch] = h;
                }
            }
        }
        LDS_WAIT();
    }
    if (MODE == 0) { p.AP[((size_t)b * NCH + ch64) * 512 + ch] = aprod; p.HE[((size_t)b * NCH + ch64) * 512 + ch] = h; }
}
__device__ __forceinline__ void lru_stage_w(const Ctx& c, PREF p, int e, int g) {
    __syncthreads();
#pragma unroll
    for (int k = 0; k < 2; ++k) { const int it = c.tid + NTHR * k, mat = it >> 9, row = (it >> 3) & 63, ck = it & 7;
        const bf16* src = (mat ? p.WxT : p.WaT) + (size_t)((e * 8 + g) * 64 + row) * 64 + 8 * ck;
        *(LAS u32x4*)((LAS bf16*)c.lds + mat * 64 * 72 + row * 72 + 8 * ck) = *(const u32x4*)src; }
    __syncthreads();
}
template <int MODE> __device__ __forceinline__ void lru_block_unit(const Ctx& c, PREF p, int e, int u) {
    if (u < N_PBU) { const int g = u & 7, chunk = (u >> 3) * 8 + c.wave, b = chunk / NCH, ch64 = chunk % NCH;
        lru_stage_w(c, p, e, g); lru_unit<MODE>(c, p, e, 0, b * SEQ + ch64 * LCH, b, ch64, g, LCH / 16); }
    else { const int v = u - N_PBU, g = v & 7, chunk = (v >> 3) * 8 + c.wave;
        lru_stage_w(c, p, e, g); lru_unit<1>(c, p, e, 1, MP + chunk * 16, 0, 0, g, 1); }
}
__device__ __forceinline__ void mixer_even(LAS unsigned char* lds, int l) {
    const int e = l / 2;
    { const Ctx c = mkctx(lds); PREF p = kparams();
      for (int u = (int)blockIdx.x; u < N_PBU + N_SBU; u += (int)gridDim.x) lru_block_unit<0>(c, p, e, u); }
    GRID_SYNC();
#ifdef PROBE_S1
    { const Ctx c = mkctx(lds); PREF p = kparams();
      for (int u = (int)blockIdx.x; u < N_PBU; u += (int)gridDim.x) lru_block_unit<0>(c, p, e, u); }
    GRID_SYNC();
#endif
    { const Ctx c = mkctx(lds); PREF p = kparams();
      for (int u = (int)blockIdx.x; u < N_PBU; u += (int)gridDim.x) lru_block_unit<1>(c, p, e, u); }
    GRID_SYNC();
}
constexpr int ST = 136, SQ = 72;
constexpr int N_R1 = BATCH * NC * 4, N_RS = DECB * 4, N_GS = DECB;
__device__ __forceinline__ bf16x8 ldsfrag(const LAS bf16* base, int row, int stride, int k0) { return *(const LAS bf16x8*)(base + row * stride + k0); }
__device__ __forceinline__ float gamma_h(int h) { return 1.0f - exp2f(-5.0f - (float)h); }
__device__ __forceinline__ void lds_transpose128(const LAS bf16* NAT, LAS bf16* DST, int tid) {
    for (int it = tid; it < 8192; it += NTHR) { const int d = (it & 7) | (((it >> 6) & 15) << 3), sp = ((it >> 3) & 7) | (((it >> 10) & 7) << 3);
        const unsigned a = NAT[(2 * sp) * ST + d], b = NAT[(2 * sp + 1) * ST + d]; *(LAS unsigned*)(DST + d * ST + 2 * sp) = a | (b << 16); }
}
__device__ __forceinline__ void stage_nat128(const bf16* src, LAS bf16* NAT, int tid) {
    u32x4 v[4];
#pragma unroll
    for (int k = 0; k < 4; ++k) { const int it = tid + NTHR * k, m = it >> 4, ck = it & 15; v[k] = *(const u32x4*)(src + (size_t)m * NIN + 8 * ck); }
#pragma unroll
    for (int k = 0; k < 4; ++k) { const int it = tid + NTHR * k, m = it >> 4, ck = it & 15; *(LAS u32x4*)(NAT + m * ST + 8 * ck) = v[k]; }
}
__device__ __forceinline__ void r1_unit(const Ctx& c, PREF p, int o, int b, int ck, int j) {
    int tid_ = c.tid; asm volatile("" : "+v"(tid_));
    const int tid = tid_, lane = tid & 63, q = lane >> 4, r16 = lane & 15, w = c.wave, row0 = b * SEQ + ck * 128;
    LAS bf16* NAT = (LAS bf16*)c.lds; LAS bf16* VT = (LAS bf16*)(c.lds + 34816); LAS bf16* KT = (LAS bf16*)(c.lds + 69632);
    stage_nat128(p.PROJ + (size_t)row0 * NIN + 512 + j * 128, NAT, tid);
    { const float lg = lgam(j);
#pragma unroll
      for (int kk = 0; kk < 4; ++kk) { const int it = tid + NTHR * kk, i = it & 31, mp = it >> 5; float av[2], bv[2];
#pragma unroll
          for (int s = 0; s < 2; ++s) { const int m = 2 * mp + s; const float* cs = p.rope + ((size_t)(ck * 128 + m) * 32 + i) * 2; const float cc = cs[0], sn = cs[1];
              const bf16* pr = p.PROJ + (size_t)(row0 + m) * NIN + 256 + j * 64 + i; const float k1 = bf2f(pr[0]), k2 = bf2f(pr[32]), f = 0.125f * expf(-(float)m * lg);
              av[s] = (k1 * cc - k2 * sn) * f; bv[s] = (k1 * sn + k2 * cc) * f; }
          *(LAS unsigned*)(KT + i * ST + 2 * mp) = pk2(av[0], av[1]); *(LAS unsigned*)(KT + (i + 32) * ST + 2 * mp) = pk2(bv[0], bv[1]); } }
    __syncthreads();
    lds_transpose128(NAT, VT, tid);
    __syncthreads();
    { bf16x8 yv[4];
#pragma unroll
      for (int ks = 0; ks < 4; ++ks) yv[ks] = ldsfrag(VT, 16 * w + r16, ST, ks * 32 + 8 * q);
      const float g127 = gpow(j, 127); float* kv = p.KVT + ((size_t)(b * NC + ck) * 4 + j) * 8192 + (16 * w + r16) * 64 + 4 * q;
#pragma unroll
      for (int dt = 0; dt < 4; ++dt) { f32x4 acc = {0.f, 0.f, 0.f, 0.f};
#pragma unroll
          for (int ks = 0; ks < 4; ++ks) acc = __builtin_amdgcn_mfma_f32_16x16x32_bf16(ldsfrag(KT, 16 * dt + r16, ST, ks * 32 + 8 * q), yv[ks], acc, 0, 0, 0);
          *(f32x4*)(kv + 16 * dt) = acc * g127; } }
    __syncthreads();
    LAS bf16* VdT = VT; LAS bf16* WL = KT;
    { f32x4 g0 = *(const f32x4*)(p.gm_ln_g + o * 512 + 8 * lane), g1 = *(const f32x4*)(p.gm_ln_g + o * 512 + 8 * lane + 4), b0 = *(const f32x4*)(p.gm_ln_b + o * 512 + 8 * lane), b1 = *(const f32x4*)(p.gm_ln_b + o * 512 + 8 * lane + 4);
      u32x4 raws[16];
#pragma unroll
      for (int rr = 0; rr < 16; ++rr) raws[rr] = *(const u32x4*)(p.PROJ + (size_t)(row0 + 16 * w + rr) * NIN + 2048 + 8 * lane);
#pragma unroll
      for (int rr = 0; rr < 16; ++rr) { const int row = 16 * w + rr; const u32x4 raw = raws[rr];
          float v[8]; v[0] = gelu_fast(bf2f((bf16)(raw.x & 0xffff))); v[1] = gelu_fast(bf2f((bf16)(raw.x >> 16))); v[2] = gelu_fast(bf2f((bf16)(raw.y & 0xffff))); v[3] = gelu_fast(bf2f((bf16)(raw.y >> 16)));
          v[4] = gelu_fast(bf2f((bf16)(raw.z & 0xffff))); v[5] = gelu_fast(bf2f((bf16)(raw.z >> 16))); v[6] = gelu_fast(bf2f((bf16)(raw.w & 0xffff))); v[7] = gelu_fast(bf2f((bf16)(raw.w >> 16)));
          float s = 0.f;
#pragma unroll
          for (int k = 0; k < 8; ++k) s += v[k];
          const float mean = wave_sum(s) * (1.0f / 512); float s2 = 0.f;
#pragma unroll
          for (int k = 0; k < 8; ++k) { v[k] -= mean; s2 += v[k] * v[k]; }
          const float rstd = 1.0f / sqrtf(wave_sum(s2) * (1.0f / 512) + LN_EPS);
          if (q == j) { u32x4 o4; o4.x = pk2(v[0] * rstd * g0.x + b0.x, v[1] * rstd * g0.y + b0.y); o4.y = pk2(v[2] * rstd * g0.z + b0.z, v[3] * rstd * g0.w + b0.w);
              o4.z = pk2(v[4] * rstd * g1.x + b1.x, v[5] * rstd * g1.y + b1.y); o4.w = pk2(v[6] * rstd * g1.z + b1.z, v[7] * rstd * g1.w + b1.w);
              *(LAS u32x4*)(NAT + row * ST + 8 * r16) = o4; } } }
    { const bf16* wsrc = p.Wtril + (size_t)((o * 4 + j) * 128) * 128;
      u32x4 v[4];
#pragma unroll
      for (int k = 0; k < 4; ++k) { const int it = tid + NTHR * k, t = it >> 4, ck2 = it & 15; v[k] = *(const u32x4*)(wsrc + t * 128 + 8 * ck2); }
#pragma unroll
      for (int k = 0; k < 4; ++k) { const int it = tid + NTHR * k, t = it >> 4, ck2 = it & 15; *(LAS u32x4*)(WL + t * ST + 8 * ck2) = v[k]; } }
    __syncthreads();
    lds_transpose128(NAT, VdT, tid);
    __syncthreads();
    { const int nks = (w >> 1) + 1, t = 16 * w + r16; bf16x8 yw[4];
#pragma unroll
      for (int ks = 0; ks < 4; ++ks) yw[ks] = ldsfrag(WL, t, ST, ks * 32 + 8 * q);
      const float sb = p.sp_b[(o * 4 + j) * 128 + t];
      const bf16* ur = p.PROJ + (size_t)(row0 + t) * NIN + 1536 + j * 128 + 4 * q; bf16* yr = p.Y + (size_t)(row0 + t) * DM + 512 + j * 128 + 4 * q;
#pragma unroll
      for (int dt = 0; dt < 8; ++dt) { f32x4 acc = {0.f, 0.f, 0.f, 0.f};
#pragma unroll
          for (int ks = 0; ks < 4; ++ks) if (ks < nks) acc = __builtin_amdgcn_mfma_f32_16x16x32_bf16(ldsfrag(VdT, 16 * dt + r16, ST, ks * 32 + 8 * q), yw[ks], acc, 0, 0, 0);
          const u32x2 uu = *(const u32x2*)(ur + 16 * dt);
          u32x2 o2; o2.x = pk2(gelu_fast(bf2f((bf16)(uu.x & 0xffff))) * (acc.x + sb), gelu_fast(bf2f((bf16)(uu.x >> 16))) * (acc.y + sb));
          o2.y = pk2(gelu_fast(bf2f((bf16)(uu.y & 0xffff))) * (acc.z + sb), gelu_fast(bf2f((bf16)(uu.y >> 16))) * (acc.w + sb));
          *(u32x2*)(yr + 16 * dt) = o2; } }
    __syncthreads();
}
__device__ __forceinline__ void r2_unit(const Ctx& c, PREF p, int o, int b, int ck, int h) {
    int tid_ = c.tid; asm volatile("" : "+v"(tid_));
    const int tid = tid_, lane = tid & 63, q = lane >> 4, r16 = lane & 15, w = c.wave, row0 = b * SEQ + ck * 128;
    LAS bf16* QL = (LAS bf16*)c.lds; LAS bf16* KL = (LAS bf16*)(c.lds + 18432); LAS bf16* S0T = (LAS bf16*)(c.lds + 36864); LAS bf16* VT = (LAS bf16*)(c.lds + 55296); LAS bf16* PM = (LAS bf16*)(c.lds + 90112);
    LAS bf16* NAT = PM;
    stage_nat128(p.PROJ + (size_t)row0 * NIN + 512 + h * 128, NAT, tid);
    { const float lg = lgam(h);
#pragma unroll
      for (int kk = 0; kk < 8; ++kk) { const int it = tid + NTHR * kk, i = it & 31, m = it >> 5; const float* cs = p.rope + ((size_t)(ck * 128 + m) * 32 + i) * 2; const float cc = cs[0], sn = cs[1];
          const bf16* pr = p.PROJ + (size_t)(row0 + m) * NIN + h * 64 + i; const float q1 = bf2f(pr[0]), q2 = bf2f(pr[32]), k1 = bf2f(pr[256]), k2 = bf2f(pr[288]);
          const float gl = expf((float)m * lg), gk = 0.125f * expf(-(float)m * lg);
          QL[m * SQ + i] = f2bf((q1 * cc - q2 * sn) * gl); QL[m * SQ + i + 32] = f2bf((q1 * sn + q2 * cc) * gl);
          KL[m * SQ + i] = f2bf((k1 * cc - k2 * sn) * gk); KL[m * SQ + i + 32] = f2bf((k1 * sn + k2 * cc) * gk); } }
    { const float g128 = gpow(h, 128);
      float S[16];
#pragma unroll
      for (int k = 0; k < 16; ++k) S[k] = 0.f;
      for (int jc = 0; jc < ck; ++jc) { const float* kv = p.KVT + ((size_t)(b * NC + jc) * 4 + h) * 8192 + tid; float v[16];
#pragma unroll
          for (int k = 0; k < 16; ++k) v[k] = kv[NTHR * k];
#pragma unroll
          for (int k = 0; k < 16; ++k) S[k] = g128 * S[k] + v[k]; }
#pragma unroll
      for (int k = 0; k < 16; ++k) { const int idx = tid + NTHR * k, e = idx >> 6, d = idx & 63; S0T[e * SQ + d] = f2bf(S[k]); }
      if (ck == NC - 1) { const float* kv = p.KVT + ((size_t)(b * NC + ck) * 4 + h) * 8192 + tid;
#pragma unroll
          for (int k = 0; k < 16; ++k) { const int idx = tid + NTHR * k, e = idx >> 6, d = idx & 63; p.out[O_RP + ((size_t)(b * 2 + o) * 4 + h) * 8192 + d * 128 + e] = g128 * S[k] + kv[NTHR * k]; } } }
    __syncthreads();
    lds_transpose128(NAT, VT, tid);
    __syncthreads();
    const int l = 16 * w + r16; bf16x8 yq[2];
#pragma unroll
    for (int ks = 0; ks < 2; ++ks) yq[ks] = ldsfrag(QL, l, SQ, ks * 32 + 8 * q);
#pragma unroll
    for (int mt = 0; mt < 8; ++mt) { f32x4 acc = {0.f, 0.f, 0.f, 0.f};
        if (mt <= w) {
#pragma unroll
            for (int ks = 0; ks < 2; ++ks) acc = __builtin_amdgcn_mfma_f32_16x16x32_bf16(ldsfrag(KL, 16 * mt + r16, SQ, ks * 32 + 8 * q), yq[ks], acc, 0, 0, 0);
            const int mb = 16 * mt + 4 * q;
            acc.x = (mb + 0 <= l) ? acc.x : 0.f; acc.y = (mb + 1 <= l) ? acc.y : 0.f; acc.z = (mb + 2 <= l) ? acc.z : 0.f; acc.w = (mb + 3 <= l) ? acc.w : 0.f; }
        u32x2 o2; o2.x = pk2(acc.x, acc.y); o2.y = pk2(acc.z, acc.w); *(LAS u32x2*)(PM + l * ST + 16 * mt + 4 * q) = o2; }
    LDS_WAIT();
    bf16x8 yp[4];
#pragma unroll
    for (int ks = 0; ks < 4; ++ks) yp[ks] = ldsfrag(PM, l, ST, ks * 32 + 8 * q);
    const int nks = (w >> 1) + 1; const float gam = gamma_h(h);
    f32x4 ov[8]; float s = 0.f;
#pragma unroll
    for (int et = 0; et < 8; ++et) { f32x4 acc = {0.f, 0.f, 0.f, 0.f};
#pragma unroll
        for (int ks = 0; ks < 2; ++ks) acc = __builtin_amdgcn_mfma_f32_16x16x32_bf16(ldsfrag(S0T, 16 * et + r16, SQ, ks * 32 + 8 * q), yq[ks], acc, 0, 0, 0);
        acc = acc * gam;
#pragma unroll
        for (int ks = 0; ks < 4; ++ks) if (ks < nks) acc = __builtin_amdgcn_mfma_f32_16x16x32_bf16(ldsfrag(VT, 16 * et + r16, ST, ks * 32 + 8 * q), yp[ks], acc, 0, 0, 0);
        ov[et] = acc; s += (acc.x + acc.y) + (acc.z + acc.w); }
    s += __shfl_xor(s, 16); s += __shfl_xor(s, 32);
    const float mean = s * (1.0f / 128); float s2 = 0.f;
#pragma unroll
    for (int et = 0; et < 8; ++et) { ov[et] = ov[et] - mean; s2 += (ov[et].x * ov[et].x + ov[et].y * ov[et].y) + (ov[et].z * ov[et].z + ov[et].w * ov[et].w); }
    s2 += __shfl_xor(s2, 16); s2 += __shfl_xor(s2, 32);
    const float rstd = 1.0f / sqrtf(s2 * (1.0f / 128) + LN_EPS);
    { const bf16* gr = p.PROJ + (size_t)(row0 + l) * NIN + 1024 + h * 128 + 4 * q; bf16* yr = p.Y + (size_t)(row0 + l) * DM + h * 128 + 4 * q; const float* gn = p.ret_gn_g + o * 512 + h * 128 + 4 * q;
#pragma unroll
      for (int et = 0; et < 8; ++et) { const u32x2 gg = *(const u32x2*)(gr + 16 * et); const f32x4 gw = *(const f32x4*)(gn + 16 * et); const f32x4 v = ov[et] * rstd * gw;
          u32x2 o2; o2.x = pk2(silu_fast(bf2f((bf16)(gg.x & 0xffff))) * v.x, silu_fast(bf2f((bf16)(gg.x >> 16))) * v.y);
          o2.y = pk2(silu_fast(bf2f((bf16)(gg.y & 0xffff))) * v.z, silu_fast(bf2f((bf16)(gg.y >> 16))) * v.w);
          *(u32x2*)(yr + 16 * et) = o2; } }
    __syncthreads();
}
__device__ __forceinline__ void rs_unit(const Ctx& c, PREF p, int o, int n, int h) {
    int tid_ = c.tid; asm volatile("" : "+v"(tid_));
    const int tid = tid_, lane = tid & 63, row0 = MP + n * 4;
    LAS float* QS = (LAS float*)c.lds; LAS float* KS = QS + 256; LAS float* VS = QS + 512; LAS float* SC = QS + 1024; LAS float* CR = QS + 1056; LAS float* RED = QS + 1056 + 2048;
    if (tid < 128) { const int l = tid >> 5, i = tid & 31; const float* cs = p.rope + ((size_t)(SEQ + l) * 32 + i) * 2; const float cc = cs[0], sn = cs[1];
        const bf16* pr = p.PROJ + (size_t)(row0 + l) * NIN + h * 64 + i; const float q1 = bf2f(pr[0]), q2 = bf2f(pr[32]), k1 = bf2f(pr[256]), k2 = bf2f(pr[288]);
        QS[l * 64 + i] = q1 * cc - q2 * sn; QS[l * 64 + i + 32] = q1 * sn + q2 * cc; KS[l * 64 + i] = 0.125f * (k1 * cc - k2 * sn); KS[l * 64 + i + 32] = 0.125f * (k1 * sn + k2 * cc); }
    { const int l = tid >> 7, e = tid & 127; VS[l * 128 + e] = bf2f(p.PROJ[(size_t)(row0 + l) * NIN + 512 + h * 128 + e]); }
    __syncthreads();
    if (tid < 16) { const int l = tid >> 2, m = tid & 3; float v = 0.f; if (m <= l) { float dot = 0.f; for (int d = 0; d < 64; ++d) dot += QS[l * 64 + d] * KS[m * 64 + d]; v = dot * gpow(h, l - m); } SC[tid] = v; }
    { const int e = tid & 127, dg = tid >> 7; const size_t base = ((size_t)(n * 2 + o) * 4 + h) * 8192; const float g4 = gpow(h, 4), k0 = gpow(h, 3), k1 = gpow(h, 2), k2 = gpow(h, 1);
      float cr0 = 0.f, cr1 = 0.f, cr2 = 0.f, cr3 = 0.f; const float v0 = VS[e], v1 = VS[128 + e], v2 = VS[256 + e], v3 = VS[384 + e];
      float s0v[16];
#pragma unroll
      for (int dd = 0; dd < 16; ++dd) s0v[dd] = p.state_ret[base + (dg * 16 + dd) * 128 + e];
#pragma unroll
      for (int dd = 0; dd < 16; ++dd) { const int d = dg * 16 + dd; const float s0 = s0v[dd];
          p.out[O_RS + base + d * 128 + e] = g4 * s0 + k0 * KS[d] * v0 + k1 * KS[64 + d] * v1 + k2 * KS[128 + d] * v2 + KS[192 + d] * v3;
          cr0 += QS[d] * s0; cr1 += QS[64 + d] * s0; cr2 += QS[128 + d] * s0; cr3 += QS[192 + d] * s0; }
      CR[(dg * 4 + 0) * 128 + e] = cr0; CR[(dg * 4 + 1) * 128 + e] = cr1; CR[(dg * 4 + 2) * 128 + e] = cr2; CR[(dg * 4 + 3) * 128 + e] = cr3; }
    __syncthreads();
    { const int l = tid >> 7, e = tid & 127; float ovv = (CR[(0 + l) * 128 + e] + CR[(4 + l) * 128 + e] + CR[(8 + l) * 128 + e] + CR[(12 + l) * 128 + e]) * gpow(h, l + 1);
      for (int m = 0; m <= l; ++m) ovv += SC[l * 4 + m] * VS[m * 128 + e];
      const float s = wave_sum(ovv); if (lane == 0) RED[c.wave] = s;
      __syncthreads();
      const float mean = (RED[2 * l] + RED[2 * l + 1]) * (1.0f / 128), d = ovv - mean; const float s2 = wave_sum(d * d); if (lane == 0) RED[8 + c.wave] = s2;
      __syncthreads();
      const float rstd = 1.0f / sqrtf((RED[8 + 2 * l] + RED[8 + 2 * l + 1]) * (1.0f / 128) + LN_EPS);
      const float gt = bf2f(p.PROJ[(size_t)(row0 + l) * NIN + 1024 + h * 128 + e]);
      p.Y[(size_t)(row0 + l) * DM + h * 128 + e] = f2bf(silu_fast(gt) * d * rstd * p.ret_gn_g[o * 512 + h * 128 + e]); }
    __syncthreads();
}
__device__ __forceinline__ void gs_unit(const Ctx& c, PREF p, int o, int n) {
    int tid_ = c.tid; asm volatile("" : "+v"(tid_));
    const int ch = tid_, g = ch >> 7, lane = ch & 63, row0 = MP + n * 4; LAS float* RED = (LAS float*)c.lds;
    float v[4], mean[4], rstd[4];
#pragma unroll
    for (int t = 0; t < 4; ++t) { v[t] = gelu_fast(bf2f(p.PROJ[(size_t)(row0 + t) * NIN + 2048 + ch])); const float s = wave_sum(v[t]); if (lane == 0) RED[t * 8 + c.wave] = s; }
    __syncthreads();
#pragma unroll
    for (int t = 0; t < 4; ++t) { float s = 0.f; for (int k = 0; k < 8; ++k) s += RED[t * 8 + k]; mean[t] = s * (1.0f / 512); v[t] -= mean[t]; }
    __syncthreads();
#pragma unroll
    for (int t = 0; t < 4; ++t) { const float s2 = wave_sum(v[t] * v[t]); if (lane == 0) RED[t * 8 + c.wave] = s2; }
    __syncthreads();
    const float gg = p.gm_ln_g[o * 512 + ch], bb = p.gm_ln_b[o * 512 + ch];
#pragma unroll
    for (int t = 0; t < 4; ++t) { float s = 0.f; for (int k = 0; k < 8; ++k) s += RED[t * 8 + k]; rstd[t] = 1.0f / sqrtf(s * (1.0f / 512) + LN_EPS); v[t] = v[t] * rstd[t] * gg + bb;
        p.out[O_CV + ((size_t)(n * 2 + o) * 4 + t) * 512 + ch] = v[t]; }
#pragma unroll
    for (int t = 0; t < 4; ++t) { float s = p.sp_b[(o * 4 + g) * 128 + t]; const float* wr = p.sp_w + ((size_t)(o * 4 + g) * 128 + t) * 128;
#pragma unroll
        for (int s2 = 0; s2 < 4; ++s2) if (s2 <= t) s += wr[s2] * v[s2];
        p.Y[(size_t)(row0 + t) * DM + 512 + ch] = f2bf(gelu_fast(bf2f(p.PROJ[(size_t)(row0 + t) * NIN + 1536 + ch])) * s); }
    __syncthreads();
}
__device__ __forceinline__ void mixer_odd(LAS unsigned char* lds, int l) {
    const int o = l / 2;
    { const Ctx c = mkctx(lds); PREF p = kparams();
      for (int u = (int)blockIdx.x; u < N_R1 + N_RS + N_GS; u += (int)gridDim.x) {
          if (u < N_R1) r1_unit(c, p, o, u / (NC * 4), (u >> 2) % NC, u & 3);
          else if (u < N_R1 + N_RS) { const int v = u - N_R1; rs_unit(c, p, o, v >> 2, v & 3); }
          else gs_unit(c, p, o, u - N_R1 - N_RS); } }
    GRID_SYNC();
#ifdef PROBE_R1
    { const Ctx c = mkctx(lds); PREF p = kparams();
      for (int u = (int)blockIdx.x; u < N_R1; u += (int)gridDim.x) r1_unit(c, p, o, u / (NC * 4), (u >> 2) % NC, u & 3); }
    GRID_SYNC();
#endif
#ifdef PROBE_RS
    { const Ctx c = mkctx(lds); PREF p = kparams();
      for (int u = N_R1 + (int)blockIdx.x; u < N_R1 + N_RS + N_GS; u += (int)gridDim.x) { if (u < N_R1 + N_RS) { const int v = u - N_R1; rs_unit(c, p, o, v >> 2, v & 3); } else gs_unit(c, p, o, u - N_R1 - N_RS); } }
    GRID_SYNC();
#endif
    { const Ctx c = mkctx(lds); PREF p = kparams();
      for (int u = (int)blockIdx.x; u < N_R1; u += (int)gridDim.x) r2_unit(c, p, o, u / (NC * 4), (u >> 2) % NC, u & 3); }
    GRID_SYNC();
}
__device__ __forceinline__ void mixer_phases(LAS unsigned char* lds, int l) {
#ifdef FAST_EVEN
    if (l % 2 == 0) { mixer_even(lds, l); return; }
#endif
#ifdef FAST_ODD
    if (l % 2 == 1) { mixer_odd(lds, l); return; }
#endif
    for (int grp = 0; grp <= BATCH; ++grp) {
        const int sample = grp == BATCH, r0 = sample ? MP : grp * SEQ, nr = sample ? MS : SEQ, T = sample ? DECS : SEQ, nseq = sample ? DECB : 1;
        if (l % 2 == 0) { const int e = l / 2;
            run_simple(FE1{kparams(), e, r0}, (long)nr * 512); GRID_SYNC(); run_simple(FE2{kparams(), e, r0}, (long)nr * 512); GRID_SYNC();
            run_simple(FE3{kparams(), e, r0, T, sample}, (long)nseq * 512); GRID_SYNC(); run_simple(FE4{kparams(), e, r0}, (long)nr * 512); GRID_SYNC();
        } else { const int o = l / 2;
            run_simple(FO1{kparams(), r0}, (long)nr * 128); GRID_SYNC();
            if (!sample) { run_simple(FO2{kparams(), grp}, (long)NC * 32768); GRID_SYNC(); run_simple(FO3{kparams(), grp, o}, 32768L); GRID_SYNC();
                run_simple(FO4{kparams()}, (long)NC * 65536); GRID_SYNC(); run_simple(FO5{kparams(), grp}, (long)NC * 65536); GRID_SYNC(); }
            else { run_simple(FO5s{kparams(), o}, (long)DECB * 2048); GRID_SYNC(); run_simple(FO3s{kparams(), o}, (long)DECB * 32768); GRID_SYNC(); }
            run_simple(FO6{kparams(), o, r0}, (long)nr * 4); GRID_SYNC(); run_simple(FO7{kparams(), o, r0}, (long)nr); GRID_SYNC(); run_simple(FO8{kparams(), o, r0}, (long)nr * 512); GRID_SYNC();
        }
    }
}

__global__ void __launch_bounds__(NTHR, 2) fwd_megakernel(P p_unused) {
    extern __shared__ __attribute__((aligned(16))) unsigned char lds_raw[];
    LAS unsigned char* lds = (LAS unsigned char*)lds_raw;
    for (int u = threadIdx.x; u < 64; u += NTHR) ((LAS unsigned*)(lds + MISC_OFF))[u] = 0u;
    if (blockIdx.x == 0) for (int u = threadIdx.x; u < XCD_BAR_WORDS; u += NTHR) __hip_atomic_store((unsigned*)(kparams().ws + WS_CTL) + u, 0u, __ATOMIC_RELAXED, __HIP_MEMORY_SCOPE_AGENT);
    __syncthreads();
    { const Ctx c = mkctx(lds); phase_prep(c); }
    cg::this_grid().sync();
    (void)xcd_barrier_post((unsigned*)(kparams().ws + WS_CTL), (volatile LAS unsigned*)(lds + MISC_OFF) + 8);
#ifdef PROBE_PREP
    { const Ctx c = mkctx(lds); phase_prep(c); }
    GRID_SYNC();
#endif
#ifdef PROBE_SYNC
    for (int i = 0; i < PROBE_SYNC; ++i) GRID_SYNC();
#endif
    for (int l = 0; l < DEPTH; ++l) {
        { const Ctx c = mkctx(lds); PREF p = kparams(); phase_gemm(c, p.XB, p.Wt_in + (size_t)l * NIN * DM, M, NIN, DM, pg8::EpiProj{p.PROJ, NIN}); }
        GRID_SYNC();
#ifdef PROBE_G1
        { const Ctx c = mkctx(lds); PREF p = kparams(); phase_gemm(c, p.XB, p.Wt_in + (size_t)l * NIN * DM, M, NIN, DM, pg8::EpiProj{p.PROJ, NIN}); }
        GRID_SYNC();
#endif
        mixer_phases(lds, l);
#ifdef PROBE_EVEN
        if (l % 2 == 0) mixer_phases(lds, l);
#endif
#ifdef PROBE_ODD
        if (l % 2 == 1) mixer_phases(lds, l);
#endif
        { const Ctx c = mkctx(lds); PREF p = kparams(); phase_gemm(c, p.Y, p.Wt_out + (size_t)l * DM * DM, MP, DM, DM, pg8::EpiRes{p.XF, DM, ALPHA});
          sample_gemm_tail(c, p.Y, p.Wt_out + (size_t)l * DM * DM, DM, p.XF, ALPHA); }
        GRID_SYNC();
        { const Ctx c = mkctx(lds); PREF p = kparams(); phase_ln(c, p.ln1_g + l * DM, p.ln1_b + l * DM); }
        GRID_SYNC();
        { const Ctx c = mkctx(lds); PREF p = kparams(); phase_gemm(c, p.XB, p.Wt_13 + (size_t)l * 2 * DFF * DM, M, 2 * DFF, DM, pg8::EpiSwiglu{p.H, DFF}); }
        GRID_SYNC();
#ifdef PROBE_G3
        { const Ctx c = mkctx(lds); PREF p = kparams(); phase_gemm(c, p.XB, p.Wt_13 + (size_t)l * 2 * DFF * DM, M, 2 * DFF, DM, pg8::EpiSwiglu{p.H, DFF}); }
        GRID_SYNC();
#endif
        { const Ctx c = mkctx(lds); PREF p = kparams(); phase_gemm(c, p.H, p.Wt_2 + (size_t)l * DM * DFF, MP, DM, DFF, pg8::EpiRes{p.XF, DM, ALPHA});
          sample_gemm_tail(c, p.H, p.Wt_2 + (size_t)l * DM * DFF, DFF, p.XF, ALPHA); }
        GRID_SYNC();
        { const Ctx c = mkctx(lds); PREF p = kparams(); phase_ln(c, p.ln2_g + l * DM, p.ln2_b + l * DM); }
        GRID_SYNC();
    }
}
extern "C" void kernel_launch(void* const* d_in, const int* in_sizes, int n_in, void* d_out, int out_size, void* d_ws, size_t ws_size, hipStream_t stream) {
    if (n_in != 30 || (long)out_size != O_END || ws_size < WS_END) { fprintf(stderr, "kernel_launch: unexpected shapes n_in %d out %d (want %ld) ws %zu (want %zu)\n", n_in, out_size, O_END, ws_size, (size_t)WS_END); return; }
    static int grid = 0;
    if (grid == 0) {
        int dev = 0, cus = 0, per_cu = 0;
        (void)hipGetDevice(&dev); (void)hipDeviceGetAttribute(&cus, hipDeviceAttributeMultiprocessorCount, dev);
        (void)hipFuncSetAttribute((const void*)fwd_megakernel, hipFuncAttributeMaxDynamicSharedMemorySize, LDS_BYTES);
        (void)hipOccupancyMaxActiveBlocksPerMultiprocessor(&per_cu, (const void*)fwd_megakernel, NTHR, LDS_BYTES);
        if (per_cu < 1) fprintf(stderr, "kernel_launch: occupancy query says %d blocks/CU\n", per_cu);
        grid = cus;
        (void)hipGetLastError();
    }
    P p{}; setup_P(p, d_in, d_out, d_ws);
    void* args[] = {&p};
    hipError_t e = hipLaunchCooperativeKernel((const void*)fwd_megakernel, dim3(grid), dim3(NTHR), args, LDS_BYTES, stream);
    if (e != hipSuccess) fprintf(stderr, "cooperative launch failed: %s (grid %d)\n", hipGetErrorString(e), grid);
}
```

```cpp
#include <hip/hip_runtime.h>
#include <cstdio>
#include <cstdint>
#define HD __host__ __device__ __forceinline__
#define CONSTAS __attribute__((address_space(4)))
#ifndef T_BATCH
#define T_BATCH 8
#endif
#ifndef T_SEQ
#define T_SEQ 2048
#endif
#ifndef T_DEC
#define T_DEC 128
#endif
typedef unsigned short bf16;
#ifndef CONSTAS
#define CONSTAS
#endif
#define PREF const CONSTAS P&
constexpr int BATCH = T_BATCH, SEQ = T_SEQ, DECB = T_DEC, DECS = 4, DM = 1024, DEPTH = 4;
constexpr int NIN = 2560, DFF = 2816, NC = SEQ / 128, PAST = 16384;
constexpr int MP = BATCH * SEQ, MS = DECB * DECS, M = MP + MS;
constexpr float ALPHA = 1.681792830507429f, LN_EPS = 1e-5f;
constexpr long O_Y = 0, O_HP = (long)M * DM, O_HS = O_HP + (long)BATCH * 1024, O_CAP = O_HS + (long)DECB * 1024, O_CAS = O_CAP + (long)BATCH * 3072,
               O_SCP = O_CAS + (long)DECB * 3072, O_SCS = O_SCP + (long)BATCH * 2048, O_RP = O_SCS + (long)DECB * 2048, O_RS = O_RP + (long)BATCH * 65536,
               O_CV = O_RS + (long)DECB * 65536, O_END = O_CV + (long)DECB * 4096;
constexpr size_t al256(size_t x) { return (x + 255) & ~(size_t)255; }
constexpr size_t WS_CTL = 0, WS_WIN = 1u << 20, WS_WOUT = WS_WIN + (size_t)4 * NIN * DM * 2, WS_W13 = WS_WOUT + (size_t)4 * DM * DM * 2,
                 WS_W2 = WS_W13 + (size_t)4 * 2 * DFF * DM * 2, WS_XB = WS_W2 + (size_t)4 * DM * DFF * 2, WS_PROJ = al256(WS_XB + (size_t)M * DM * 2),
                 WS_Y = al256(WS_PROJ + (size_t)M * NIN * 2), WS_ROPE = al256(WS_Y + (size_t)M * DM * 2), WS_WAT = al256(WS_ROPE + (size_t)(SEQ + 4) * 64 * 4), WS_WXT = WS_WAT + 131072, WS_AP = WS_WXT + 131072,
                 WS_HE = WS_AP + (size_t)BATCH * (SEQ / 64) * 512 * 4, WS_WTRIL = WS_HE + (size_t)BATCH * (SEQ / 64) * 512 * 4, WS_KVT = WS_WTRIL + (size_t)2 * 4 * 128 * 128 * 2,
                 WS_SCR = al256(WS_KVT + (size_t)BATCH * NC * 4 * 8192 * 4);
constexpr size_t WS_H = WS_PROJ;
static_assert((size_t)M * DFF * 2 <= WS_ROPE - WS_PROJ, "H overlay");
constexpr int GR = (SEQ > MS ? SEQ : MS);
constexpr size_t SCR_A = 0, SCR_B = SCR_A + (size_t)GR * 512 * 4, SCR_C = SCR_B + (size_t)GR * 512 * 4, SCR_D = SCR_C + (size_t)GR * 512 * 4,
                 SCR_E = SCR_D + (size_t)NC * 4 * 8192 * 4, SCR_F = SCR_E + (size_t)NC * 4 * 8192 * 4, SCR_END = SCR_F + (size_t)NC * 4 * 16384 * 4;
constexpr size_t WS_END = WS_SCR + SCR_END;

struct P {
    const float *x_prompt, *x_sample, *state_lru_h, *state_lru_conv, *state_sconv, *state_ret;
    const float *w_in_even, *conv_a_w, *conv_a_b, *lru_wa, *lru_ba, *lru_wx, *lru_bx, *lru_lam, *conv_b_w, *w_out_even;
    const float *w_in_odd, *ret_gn_g, *sp_w, *sp_b, *gm_ln_g, *gm_ln_b, *w_out_odd;
    const float *ffn_w1, *ffn_w3, *ffn_w2, *ln1_g, *ln1_b, *ln2_g, *ln2_b;
    float* out; unsigned char* ws;
    bf16 *Wt_in, *Wt_out, *Wt_13, *Wt_2, *XB, *PROJ, *Y, *H;
    float *XF, *rope, *sA, *sB, *sC, *sD, *sE, *sF;
    bf16 *WaT, *WxT, *Wtril; float *AP, *HE, *KVT;
};
static inline void setup_P(P& p, void* const* d_in, void* d_out, void* d_ws) {
    const float** f = (const float**)&p.x_prompt;
    for (int i = 0; i < 30; ++i) f[i] = (const float*)d_in[i];
    p.out = (float*)d_out; p.ws = (unsigned char*)d_ws;
    p.Wt_in = (bf16*)(p.ws + WS_WIN); p.Wt_out = (bf16*)(p.ws + WS_WOUT); p.Wt_13 = (bf16*)(p.ws + WS_W13); p.Wt_2 = (bf16*)(p.ws + WS_W2);
    p.XB = (bf16*)(p.ws + WS_XB); p.PROJ = (bf16*)(p.ws + WS_PROJ); p.Y = (bf16*)(p.ws + WS_Y); p.H = (bf16*)(p.ws + WS_H);
    p.XF = p.out; p.rope = (float*)(p.ws + WS_ROPE);
    p.WaT = (bf16*)(p.ws + WS_WAT); p.WxT = (bf16*)(p.ws + WS_WXT); p.Wtril = (bf16*)(p.ws + WS_WTRIL); p.AP = (float*)(p.ws + WS_AP); p.HE = (float*)(p.ws + WS_HE); p.KVT = (float*)(p.ws + WS_KVT);
    unsigned char* s = p.ws + WS_SCR;
    p.sA = (float*)(s + SCR_A); p.sB = (float*)(s + SCR_B); p.sC = (float*)(s + SCR_C); p.sD = (float*)(s + SCR_D); p.sE = (float*)(s + SCR_E); p.sF = (float*)(s + SCR_F);
}

HD bf16 f2bf(float f) { unsigned u = __builtin_bit_cast(unsigned, f); return (bf16)((u + 0x7fffu + ((u >> 16) & 1u)) >> 16); }
HD float bf2f(bf16 h) { return __builtin_bit_cast(float, (unsigned)h << 16); }
HD float sigmoidf_(float x) { return 1.0f / (1.0f + expf(-x)); }
HD float siluf_(float x) { return x * sigmoidf_(x); }
HD float geluf_(float x) { return 0.5f * x * (1.0f + tanhf(0.7978845608028654f * (x + 0.044715f * x * x * x))); }
HD float lgam(int h) { return h == 0 ? -0.0317486983145803f : h == 1 ? -0.015748356968139168f : h == 2 ? -0.007843177461025893f : -0.003913899321136329f; }
HD float gpow(int h, int n) { return expf((float)n * lgam(h)); }
struct RowInfo { int sample, s, t, T, base; };
HD RowInfo rowinfo(int row) { RowInfo r; if (row < MP) { r.sample = 0; r.s = row / SEQ; r.t = row % SEQ; r.T = SEQ; r.base = r.s * SEQ; } else { int q = row - MP; r.sample = 1; r.s = q / DECS; r.t = q % DECS; r.T = DECS; r.base = MP + r.s * DECS; } return r; }

struct FPrepW { const float* W; bf16* Wt; int K, N;
    HD void operator()(long g) const { int n = (int)(g / K), k = (int)(g % K); Wt[g] = f2bf(W[(long)k * N + n]); } };
struct FPrepW13 { const float* W; bf16* Wt; int half, pad_;
    HD void operator()(long g) const { int j = (int)(g / DM), k = (int)(g % DM); Wt[(long)((j >> 7) * 256 + half * 128 + (j & 127)) * DM + k] = f2bf(W[(long)k * DFF + j]); } };
struct FPrepX { PREF p;
    HD void operator()(long g) const { float v = g < (long)MP * DM ? p.x_prompt[g] : p.x_sample[g - (long)MP * DM]; p.XF[g] = v; p.XB[g] = f2bf(v); } };
struct FRope { float* cs;
    HD void operator()(long g) const { int pi = (int)(g / 32), i = (int)(g % 32); double pos = pi < SEQ ? (double)pi : (double)(PAST + pi - SEQ);
        double fr = 1.0; for (int j = 0; j < i; ++j) fr *= 0.7498942093324559;
        double ang = pos * fr, k = rint(ang * 0.15915494309189535), r = ang - k * 6.283185307179586; r -= k * 2.4492935982947064e-16;
        double r2 = r * r, sn = 0.0, cn = 0.0;
        for (int n = 14; n >= 1; --n) { sn = (sn + 1.0) * (-r2 / ((2.0 * n) * (2.0 * n + 1.0))); cn = (cn + 1.0) * (-r2 / ((2.0 * n - 1.0) * (2.0 * n))); }
        cs[2 * g] = (float)(cn + 1.0); cs[2 * g + 1] = (float)(r * (sn + 1.0)); } };

struct FLN { PREF p; const float* g; const float* b;
    HD void operator()(long row) const { float* z = p.XF + row * DM; float mu = 0.f; for (int c = 0; c < DM; ++c) mu += z[c]; mu *= (1.0f / DM);
        float var = 0.f; for (int c = 0; c < DM; ++c) { float d = z[c] - mu; var += d * d; } var *= (1.0f / DM); float rs = 1.0f / sqrtf(var + LN_EPS);
        for (int c = 0; c < DM; ++c) { float v = (z[c] - mu) * rs * g[c] + b[c]; z[c] = v; p.XB[row * DM + c] = f2bf(v); } } };

struct FE1 { PREF p; int e, r0;
    HD void operator()(long g) const { int row = r0 + (int)(g / 512), ch = (int)(g % 512); RowInfo ri = rowinfo(row);
        float acc = p.conv_a_b[e * 512 + ch];
        for (int j = 0; j < 4; ++j) { int tt = ri.t - 3 + j; float xv;
            if (tt >= 0) xv = bf2f(p.PROJ[(long)(ri.base + tt) * NIN + ch]); else xv = ri.sample ? p.state_lru_conv[((long)(ri.s * 2 + e) * 3 + (3 + tt)) * 512 + ch] : 0.f;
            acc += p.conv_a_w[(e * 4 + j) * 512 + ch] * xv; }
        p.sA[g] = acc;
        if (ri.t >= ri.T - 3) { float xv = bf2f(p.PROJ[(long)row * NIN + ch]); int j = ri.t - (ri.T - 3);
            p.out[(ri.sample ? O_CAS : O_CAP) + ((long)(ri.s * 2 + e) * 3 + j) * 512 + ch] = xv; } } };
struct FE2 { PREF p; int e, r0;
    HD void operator()(long g) const { int row = r0 + (int)(g / 512), ch = (int)(g % 512), g8 = ch >> 6, jj = ch & 63; RowInfo ri = rowinfo(row);
        const float* xc = p.sA + (long)(row - r0) * 512 + g8 * 64; const float* wa = p.lru_wa + (long)((e * 8 + g8) * 64) * 64 + jj; const float* wx = p.lru_wx + (long)((e * 8 + g8) * 64) * 64 + jj;
        float rp = p.lru_ba[e * 512 + ch], ip = p.lru_bx[e * 512 + ch];
        for (int i = 0; i < 64; ++i) { rp += xc[i] * wa[i * 64]; ip += xc[i] * wx[i * 64]; }
        float r = sigmoidf_(rp), ii = sigmoidf_(ip), sp = log1pf(expf(-p.lru_lam[e * 512 + ch]));
        float la = -8.0f * r * sp, a = expf(la), mult = sqrtf(-expm1f(2.0f * la));
        if (!ri.sample && ri.t == 0) mult = 1.0f;
        p.sB[g] = a; p.sC[g] = mult * (ii * xc[jj]); } };
struct FE3 { PREF p; int e, r0, T, sample;
    HD void operator()(long g) const { int si = (int)(g / 512), ch = (int)(g % 512); int rowb = r0 + si * T;
        float h = sample ? p.state_lru_h[(long)(si * 2 + e) * 512 + ch] : 0.f;
        for (int t = 0; t < T; ++t) { long idx = (long)(rowb - r0 + t) * 512 + ch; h = p.sB[idx] * h + p.sC[idx];
            float ga = bf2f(p.PROJ[(long)(rowb + t) * NIN + 512 + ch]); p.Y[(long)(rowb + t) * DM + ch] = f2bf(h * geluf_(ga)); }
        int s = sample ? si : r0 / SEQ;
        p.out[(sample ? O_HS : O_HP) + (long)(s * 2 + e) * 512 + ch] = h; } };
struct FE4 { PREF p; int e, r0;
    HD void operator()(long g) const { int row = r0 + (int)(g / 512), ch = (int)(g % 512); RowInfo ri = rowinfo(row);
        float zb = 0.f, cur = 0.f;
        for (int j = 0; j < 3; ++j) { int tt = ri.t - 2 + j; float cx;
            if (tt >= 0) cx = bf2f(p.PROJ[(long)(ri.base + tt) * NIN + 1536 + ch]) * bf2f(p.PROJ[(long)(ri.base + tt) * NIN + 2048 + ch]);
            else cx = ri.sample ? p.state_sconv[((long)(ri.s * 2 + e) * 2 + (2 + tt)) * 512 + ch] : 0.f;
            zb += p.conv_b_w[(e * 3 + j) * 512 + ch] * cx; cur = cx; }
        p.Y[(long)row * DM + 512 + ch] = f2bf(bf2f(p.PROJ[(long)row * NIN + 1024 + ch]) * zb);
        if (ri.t >= ri.T - 2) p.out[(ri.sample ? O_SCS : O_SCP) + ((long)(ri.s * 2 + e) * 2 + (ri.t - (ri.T - 2))) * 512 + ch] = cur; } };

struct FO1 { PREF p; int r0, pad_;
    HD void operator()(long g) const { int row = r0 + (int)(g / 128), hh = (int)((g % 128) / 32), i = (int)(g % 32); RowInfo ri = rowinfo(row);
        int pi = ri.sample ? SEQ + ri.t : ri.t; float c = p.rope[(pi * 32 + i) * 2], s = p.rope[(pi * 32 + i) * 2 + 1];
        const bf16* pr = p.PROJ + (long)row * NIN; long o = (long)(row - r0) * 256 + hh * 64 + i;
        float q1 = bf2f(pr[hh * 64 + i]), q2 = bf2f(pr[hh * 64 + 32 + i]); p.sA[o] = q1 * c - q2 * s; p.sA[o + 32] = q1 * s + q2 * c;
        float k1 = bf2f(pr[256 + hh * 64 + i]), k2 = bf2f(pr[256 + hh * 64 + 32 + i]); p.sB[o] = 0.125f * (k1 * c - k2 * s); p.sB[o + 32] = 0.125f * (k1 * s + k2 * c); } };
struct FO2 { PREF p; int b, pad_;
    HD void operator()(long g) const { int e = (int)(g % 128), d = (int)((g / 128) % 64), hh = (int)((g / 8192) % 4), c = (int)(g / 32768);
        float acc = 0.f;
        for (int m = 0; m < 128; ++m) { int lr = c * 128 + m; acc += p.sB[(long)lr * 256 + hh * 64 + d] * gpow(hh, 127 - m) * bf2f(p.PROJ[(long)(b * SEQ + lr) * NIN + 512 + hh * 128 + e]); }
        p.sD[g] = acc; } };
struct FO3 { PREF p; int b, o;
    HD void operator()(long g) const { int hh = (int)(g / 8192); float S = 0.f, g128 = gpow(hh, 128);
        for (int c = 0; c < NC; ++c) { long i = (long)c * 32768 + g; p.sE[i] = S; S = g128 * S + p.sD[i]; }
        p.out[O_RP + (long)((b * 2 + o) * 4) * 8192 + g] = S; } };
struct FO4 { PREF p;
    HD void operator()(long g) const { int m = (int)(g % 128), l = (int)((g / 128) % 128), hh = (int)((g / 16384) % 4), c = (int)(g / 65536);
        float v = 0.f;
        if (m <= l) { const float* q = p.sA + (long)(c * 128 + l) * 256 + hh * 64; const float* k = p.sB + (long)(c * 128 + m) * 256 + hh * 64; float dot = 0.f; for (int d = 0; d < 64; ++d) dot += q[d] * k[d]; v = dot * gpow(hh, l - m); }
        p.sF[g] = v; } };
struct FO5 { PREF p; int b, pad_;
    HD void operator()(long g) const { int e = (int)(g % 128), l = (int)((g / 128) % 128), hh = (int)((g / 16384) % 4), c = (int)(g / 65536);
        const float* pm = p.sF + (long)(c * 4 + hh) * 16384 + l * 128; float acc = 0.f;
        for (int m = 0; m <= l; ++m) acc += pm[m] * bf2f(p.PROJ[(long)(b * SEQ + c * 128 + m) * NIN + 512 + hh * 128 + e]);
        const float* q = p.sA + (long)(c * 128 + l) * 256 + hh * 64; const float* s0 = p.sE + (long)(c * 4 + hh) * 8192 + e; float cr = 0.f; for (int d = 0; d < 64; ++d) cr += q[d] * s0[d * 128];
        p.sC[(long)(c * 128 + l) * 512 + hh * 128 + e] = acc + gpow(hh, l + 1) * cr; } };
struct FO5s { PREF p; int o, pad_;
    HD void operator()(long g) const { int e = (int)(g % 128), hh = (int)((g / 128) % 4), l = (int)((g / 512) % 4), n = (int)(g / 2048);
        const float* q = p.sA + (long)(n * 4 + l) * 256 + hh * 64; float acc = 0.f;
        for (int m = 0; m <= l; ++m) { const float* k = p.sB + (long)(n * 4 + m) * 256 + hh * 64; float dot = 0.f; for (int d = 0; d < 64; ++d) dot += q[d] * k[d];
            acc += gpow(hh, l - m) * dot * bf2f(p.PROJ[(long)(MP + n * 4 + m) * NIN + 512 + hh * 128 + e]); }
        const float* s0 = p.state_ret + (long)((n * 2 + o) * 4 + hh) * 8192 + e; float cr = 0.f; for (int d = 0; d < 64; ++d) cr += q[d] * s0[d * 128];
        p.sC[(long)(n * 4 + l) * 512 + hh * 128 + e] = acc + gpow(hh, l + 1) * cr; } };
struct FO3s { PREF p; int o, pad_;
    HD void operator()(long g) const { int e = (int)(g % 128), d = (int)((g / 128) % 64), hh = (int)((g / 8192) % 4), n = (int)(g / 32768);
        long si = (long)((n * 2 + o) * 4 + hh) * 8192 + d * 128 + e; float S = gpow(hh, 4) * p.state_ret[si];
        for (int l = 0; l < 4; ++l) S += gpow(hh, 3 - l) * p.sB[(long)(n * 4 + l) * 256 + hh * 64 + d] * bf2f(p.PROJ[(long)(MP + n * 4 + l) * NIN + 512 + hh * 128 + e]);
        p.out[O_RS + si] = S; } };
struct FO6 { PREF p; int o, r0;
    HD void operator()(long g) const { int row = r0 + (int)(g / 4), hh = (int)(g % 4); const float* ov = p.sC + (long)(row - r0) * 512 + hh * 128;
        float mu = 0.f; for (int e = 0; e < 128; ++e) mu += ov[e]; mu *= (1.0f / 128); float var = 0.f; for (int e = 0; e < 128; ++e) { float d = ov[e] - mu; var += d * d; } var *= (1.0f / 128);
        float rs = 1.0f / sqrtf(var + LN_EPS);
        for (int e = 0; e < 128; ++e) { float gt = bf2f(p.PROJ[(long)row * NIN + 1024 + hh * 128 + e]); p.Y[(long)row * DM + hh * 128 + e] = f2bf(siluf_(gt) * ((ov[e] - mu) * rs) * p.ret_gn_g[o * 512 + hh * 128 + e]); } } };
struct FO7 { PREF p; int o, r0;
    HD void operator()(long g) const { int row = r0 + (int)g; const bf16* pr = p.PROJ + (long)row * NIN + 2048; float* vd = p.sB + g * 512;
        float mu = 0.f; for (int c = 0; c < 512; ++c) { float v = geluf_(bf2f(pr[c])); vd[c] = v; mu += v; } mu *= (1.0f / 512);
        float var = 0.f; for (int c = 0; c < 512; ++c) { float d = vd[c] - mu; var += d * d; } var *= (1.0f / 512); float rs = 1.0f / sqrtf(var + LN_EPS);
        RowInfo ri = rowinfo(row);
        for (int c = 0; c < 512; ++c) { float v = (vd[c] - mu) * rs * p.gm_ln_g[o * 512 + c] + p.gm_ln_b[o * 512 + c]; vd[c] = v;
            if (ri.sample) p.out[O_CV + ((long)(ri.s * 2 + o) * 4 + ri.t) * 512 + c] = v; } } };
struct FO8 { PREF p; int o, r0;
    HD void operator()(long g) const { int row = r0 + (int)(g / 512), ch = (int)(g % 512), gg = ch >> 7; RowInfo ri = rowinfo(row);
        int tl = ri.sample ? ri.t : (ri.t & 127), cb = row - tl;
        float s = p.sp_b[(o * 4 + gg) * 128 + tl]; const float* w = p.sp_w + ((long)(o * 4 + gg) * 128 + tl) * 128;
        for (int s2 = 0; s2 <= tl; ++s2) s += w[s2] * p.sB[(long)(cb + s2 - r0) * 512 + ch];
        p.Y[(long)row * DM + 512 + ch] = f2bf(geluf_(bf2f(p.PROJ[(long)row * NIN + 1536 + ch])) * s); } };
namespace pg8 {
#define PG8_LAS __attribute__((address_space(3)))
typedef unsigned short bf16_t;
typedef short bf16x8 __attribute__((ext_vector_type(8)));
typedef float f32x4 __attribute__((ext_vector_type(4)));
typedef unsigned u32x4 __attribute__((ext_vector_type(4)));
constexpr int BM = 256, BK = 64, HALF = 128, HTB = HALF * BK * 2  , STAGE_BYTES = 8 * HTB, NXCD = 8, WGM = 8;

__host__ __device__ __forceinline__ int lds_byte(int r, int c) { const int st = (r >> 4) * 2 + (c >> 5), rr = r & 15, cc = c & 31, ob = rr * 64 + cc * 2; return st * 1024 + (ob ^ (((ob >> 9) & 1) << 5)); }
__host__ __device__ __forceinline__ void stage_rc(int b, int& R, int& C) { const int st = b / 1024, sb = b % 1024, swz = sb ^ (((sb >> 9) & 1) << 5); R = (st >> 1) * 16 + swz / 64; C = (st & 1) * 32 + (swz % 64) / 2; }
__host__ __device__ __forceinline__ int perm32(int rho) { const int n = rho >> 4, i = rho & 15; return 8 * (i >> 2) + 4 * n + (i & 3); }

struct Unit { int pm, pn; };
struct Gemm { const bf16_t* A; const bf16_t* Bt; int M, N, K; };

struct StaticOrder {
    int nM, nN, nwg, G, c;
    __host__ __device__ void init(int M, int N, int G_, int c_) { nM = M / BM; nN = N / BM; nwg = nM * nN; G = G_; c = c_; }
    __host__ __device__ bool next(int i, Unit& u) const {
        const long L = (long)i * G + c; if (L >= nwg) return false;
        int wgid = (int)L; { const int q = nwg / NXCD, r = nwg % NXCD, xcd = wgid % NXCD, off = wgid / NXCD; wgid = (xcd < r ? xcd * (q + 1) : r * (q + 1) + (xcd - r) * q) + off; }
        const int nig = WGM * nN, gid = wgid / nig, fm = gid * WGM, gsz = (nM - fm) < WGM ? (nM - fm) : WGM;
        u.pm = fm + ((wgid % nig) % gsz); u.pn = (wgid % nig) / gsz; return true;
    }
    __device__ __forceinline__ void a_ready(const Unit&) const {}
    __device__ __forceinline__ void done(const Unit&) const {}
};

__device__ __forceinline__ unsigned cvt_pk_bf16(float lo, float hi) { unsigned r; asm volatile("v_cvt_pk_bf16_f32 %0, %1, %2" : "=v"(r) : "v"(lo), "v"(hi)); return r; }
struct EpiProj {
    static constexpr bool PERM = true, AFTER_DRAIN = false;
    bf16_t* O; int ldc;
    __device__ __forceinline__ void operator()(const f32x4 (&acc)[2][2][4][2], const Unit& u, int wr, int wc, int fr, int fq) const {
        const int row0 = u.pm * BM + wr * 64 + fr, col0 = u.pn * BM + wc * 32 + 8 * fq;
#pragma unroll
        for (int ai = 0; ai < 2; ++ai)
#pragma unroll
            for (int m = 0; m < 4; ++m) { bf16_t* rowp = O + (size_t)(row0 + ai * HALF + m * 16) * ldc + col0;
#pragma unroll
                for (int bj = 0; bj < 2; ++bj) { const f32x4 v0 = acc[ai][bj][m][0], v1 = acc[ai][bj][m][1];
                    u32x4 w; w.x = cvt_pk_bf16(v0[0], v0[1]); w.y = cvt_pk_bf16(v0[2], v0[3]); w.z = cvt_pk_bf16(v1[0], v1[1]); w.w = cvt_pk_bf16(v1[2], v1[3]);
                    *(u32x4*)(rowp + bj * HALF) = w; } }
    }
};
__device__ __forceinline__ float silu_f(float x) { return x * __builtin_amdgcn_rcpf(1.0f + __builtin_amdgcn_exp2f(-1.4426950409f * x)); }
struct EpiSwiglu {
    static constexpr bool PERM = true, AFTER_DRAIN = false;
    bf16_t* O; int ldc;
    __device__ __forceinline__ void operator()(const f32x4 (&acc)[2][2][4][2], const Unit& u, int wr, int wc, int fr, int fq) const {
        const int row0 = u.pm * BM + wr * 64 + fr, col0 = u.pn * HALF + wc * 32 + 8 * fq;
#pragma unroll
        for (int ai = 0; ai < 2; ++ai)
#pragma unroll
            for (int m = 0; m < 4; ++m) { bf16_t* rowp = O + (size_t)(row0 + ai * HALF + m * 16) * ldc + col0;
                float h[8];
#pragma unroll
                for (int n = 0; n < 2; ++n)
#pragma unroll
                    for (int i = 0; i < 4; ++i) h[n * 4 + i] = silu_f(acc[ai][0][m][n][i]) * acc[ai][1][m][n][i];
                u32x4 w; w.x = cvt_pk_bf16(h[0], h[1]); w.y = cvt_pk_bf16(h[2], h[3]); w.z = cvt_pk_bf16(h[4], h[5]); w.w = cvt_pk_bf16(h[6], h[7]);
                *(u32x4*)rowp = w; }
    }
};
struct EpiRes {
    static constexpr bool PERM = false, AFTER_DRAIN = false;
    const float* X; int ldc; float alpha; float* Xo; int omask;
    __device__ __forceinline__ void operator()(const f32x4 (&acc)[2][2][4][2], const Unit& u, int wr, int wc, int fr, int fq) const {
        const int row0 = u.pm * BM + wr * 64 + fr, col0 = u.pn * BM + wc * 32 + 4 * fq;
#pragma unroll
        for (int ai = 0; ai < 2; ++ai)
#pragma unroll
            for (int m = 0; m < 4; ++m) { const int row = row0 + ai * HALF + m * 16; const float* rowp = X + (size_t)row * ldc + col0; float* rowo = Xo + (size_t)(row & omask) * ldc + col0;
#pragma unroll
                for (int bj = 0; bj < 2; ++bj)
#pragma unroll
                    for (int n = 0; n < 2; ++n) { *(f32x4*)(rowo + bj * HALF + n * 16) = *(const f32x4*)(rowp + bj * HALF + n * 16) * alpha + acc[ai][bj][m][n]; } }
    }
};
template <class Epi, class Sched, bool ALIGN_EPI = false, bool SP2 = false>
__device__ __forceinline__ void gemm_phase(PG8_LAS unsigned char* lds, const Gemm g, const Sched& S, const Epi& E) {
    int tid_ = threadIdx.x; asm volatile("" : "+v"(tid_)); const int tid = tid_, wid = __builtin_amdgcn_readfirstlane(tid >> 6), lane = tid & 63, wr = wid >> 2, wc = wid & 3, fr = lane & 15, fq = lane >> 4;
    const int K = g.K, nt = K / BK;
    unsigned voffA[2], voffB[2];
#pragma unroll
    for (int i = 0; i < 2; ++i) { int R, C; stage_rc(tid * 16 + i * 8192, R, C); const int Rb = Epi::PERM ? ((R & ~31) + perm32(R & 31)) : R;
        voffA[i] = (unsigned)(R * K + C) * 2u; voffB[i] = (unsigned)(Rb * K + C) * 2u; }
    const size_t kstep = (size_t)(BK * 2);
    const size_t hstep = (size_t)HALF * K * 2;
    const size_t tstep = 2 * hstep;
    const unsigned ldsw = (unsigned)wid * 1024u;
    const int aoff = lds_byte(wr * 64 + fr, fq * 8), boff = lds_byte(wc * 32 + fr, fq * 8);
#define PG8_SA(b, h) (((b) * 2 + (h)) * HTB)
#define PG8_SB(b, h) ((4 + (b) * 2 + (h)) * HTB)
#define PG8_STAGE(bufoff, gbase, voff) do { _Pragma("unroll") for (int _i = 0; _i < 2; ++_i) \
        __builtin_amdgcn_global_load_lds((const unsigned*)((const char*)(gbase) + (voff)[_i]), (PG8_LAS unsigned*)(lds + (bufoff) + ldsw + _i * 8192), 16, 0, 0); } while (0)
#define PG8_LDA(dst, b, h) do { _Pragma("unroll") for (int m = 0; m < 4; ++m) _Pragma("unroll") for (int k = 0; k < 2; ++k) dst[m][k] = *(const PG8_LAS bf16x8*)(lds + PG8_SA(b, h) + aoff + m * 2048 + k * 1024); } while (0)
#define PG8_LDB(dst, b, h) do { _Pragma("unroll") for (int n = 0; n < 2; ++n) _Pragma("unroll") for (int k = 0; k < 2; ++k) dst[n][k] = *(const PG8_LAS bf16x8*)(lds + PG8_SB(b, h) + boff + n * 2048 + k * 1024); } while (0)
#define PG8_MMA(ai, bj, At, Bt) do { __builtin_amdgcn_s_setprio(1); _Pragma("unroll") for (int m = 0; m < 4; ++m) _Pragma("unroll") for (int n = 0; n < 2; ++n) _Pragma("unroll") for (int k = 0; k < 2; ++k) \
        acc[ai][bj][m][n] = __builtin_amdgcn_mfma_f32_16x16x32_bf16(Bt[n][k], At[m][k], acc[ai][bj][m][n], 0, 0, 0); __builtin_amdgcn_s_setprio(0); } while (0)
#define PG8_WAIT_V(n) asm volatile("s_waitcnt vmcnt(" #n ")" ::: "memory")
#define PG8_WAIT_L(n) asm volatile("s_waitcnt lgkmcnt(" #n ")" ::: "memory")
#define PG8_BAR __builtin_amdgcn_s_barrier()
#define PG8_SCHED __builtin_amdgcn_sched_barrier(0)
    Unit cur, nxt; int ui = 0;
    if (!S.next(0, cur)) return;
    f32x4 acc[2][2][4][2];
#pragma unroll
    for (int a = 0; a < 2; ++a)
#pragma unroll
        for (int b = 0; b < 2; ++b)
#pragma unroll
            for (int m = 0; m < 4; ++m)
#pragma unroll
                for (int n = 0; n < 2; ++n) acc[a][b][m][n] = (f32x4){0.f, 0.f, 0.f, 0.f};
    bf16x8 At[4][2], B0[2][2], B1[2][2];
    const char* cA = (const char*)g.A + (size_t)cur.pm * tstep; const char* cB = (const char*)g.Bt + (size_t)cur.pn * tstep;
    S.a_ready(cur);
    if constexpr (SP2) {
        PG8_STAGE(PG8_SB(0, 0), cB, voffB); PG8_STAGE(PG8_SB(0, 1), cB + hstep, voffB); PG8_STAGE(PG8_SA(0, 0), cA, voffA); PG8_STAGE(PG8_SA(0, 1), cA + hstep, voffA);
        if (wr == 1) PG8_BAR;
        PG8_WAIT_V(2); PG8_BAR;
        PG8_STAGE(PG8_SB(1, 0), cB + kstep, voffB); PG8_STAGE(PG8_SA(1, 0), cA + kstep, voffA); PG8_STAGE(PG8_SB(1, 1), cB + hstep + kstep, voffB);
        PG8_WAIT_V(6); PG8_BAR;
    } else {
        PG8_STAGE(PG8_SB(0, 0), cB, voffB); PG8_STAGE(PG8_SA(0, 0), cA, voffA); PG8_STAGE(PG8_SB(0, 1), cB + hstep, voffB); PG8_STAGE(PG8_SA(0, 1), cA + hstep, voffA);
        if (wr == 1) PG8_BAR;
        PG8_WAIT_V(4); PG8_BAR;
        PG8_STAGE(PG8_SB(1, 0), cB + kstep, voffB); PG8_STAGE(PG8_SA(1, 0), cA + kstep, voffA); PG8_STAGE(PG8_SB(1, 1), cB + hstep + kstep, voffB);
        PG8_WAIT_V(6); PG8_BAR;
    }
    for (;;) {
        const bool has_next = S.next(ui + 1, nxt);
        const char* nA = has_next ? (const char*)g.A + (size_t)nxt.pm * tstep : cA; const char* nB = has_next ? (const char*)g.Bt + (size_t)nxt.pn * tstep : cB;
        for (int t = 0; t < nt; t += 2) {
            const bool last = (t == nt - 2);
            const char* a1 = cA + (size_t)(t + 1) * kstep;
            const char* a2 = last ? nA : cA + (size_t)(t + 2) * kstep; const char* b2 = last ? nB : cB + (size_t)(t + 2) * kstep;
            const char* a3 = a2 + kstep; const char* b3 = b2 + kstep;
            if (last && has_next) S.a_ready(nxt);
            if constexpr (SP2) {
            PG8_LDB(B0, 0, 0); PG8_LDB(B1, 0, 1); PG8_SCHED; PG8_LDA(At, 0, 0); PG8_STAGE(PG8_SA(1, 1), a1 + hstep, voffA);
            PG8_WAIT_V(8); PG8_WAIT_L(0); PG8_BAR; PG8_MMA(0, 0, At, B0); PG8_MMA(0, 1, At, B1); PG8_BAR; PG8_SCHED;
            PG8_LDA(At, 0, 1); PG8_STAGE(PG8_SB(0, 0), b2, voffB); PG8_STAGE(PG8_SB(0, 1), b2 + hstep, voffB); PG8_STAGE(PG8_SA(0, 0), a2, voffA);
            PG8_WAIT_V(8); PG8_WAIT_L(0); PG8_BAR; PG8_MMA(1, 0, At, B0); PG8_MMA(1, 1, At, B1); PG8_BAR; PG8_SCHED;
            PG8_LDB(B0, 1, 0); PG8_LDB(B1, 1, 1); PG8_SCHED; PG8_LDA(At, 1, 0); PG8_STAGE(PG8_SA(0, 1), a2 + hstep, voffA);
            PG8_WAIT_V(8); PG8_WAIT_L(0); PG8_BAR; PG8_MMA(0, 0, At, B0); PG8_MMA(0, 1, At, B1); PG8_BAR; PG8_SCHED;
            PG8_LDA(At, 1, 1); PG8_STAGE(PG8_SB(1, 0), b3, voffB); PG8_STAGE(PG8_SB(1, 1), b3 + hstep, voffB); PG8_STAGE(PG8_SA(1, 0), a3, voffA);
            PG8_WAIT_V(8); PG8_WAIT_L(0); PG8_BAR; PG8_MMA(1, 0, At, B0); PG8_MMA(1, 1, At, B1); PG8_BAR; PG8_SCHED;
            } else {
            PG8_LDB(B0, 0, 0); PG8_SCHED; PG8_LDA(At, 0, 0); PG8_STAGE(PG8_SA(1, 1), a1 + hstep, voffA);
            PG8_WAIT_L(8); PG8_BAR; PG8_WAIT_L(0); PG8_MMA(0, 0, At, B0); PG8_BAR; PG8_SCHED;
            PG8_LDB(B1, 0, 1); PG8_STAGE(PG8_SB(0, 0), b2, voffB);
            PG8_BAR; PG8_WAIT_L(0); PG8_MMA(0, 1, At, B1); PG8_BAR;
            PG8_LDA(At, 0, 1); PG8_STAGE(PG8_SA(0, 0), a2, voffA);
            PG8_BAR; PG8_WAIT_L(0); PG8_MMA(1, 0, At, B0); PG8_BAR; PG8_SCHED;
            PG8_STAGE(PG8_SB(0, 1), b2 + hstep, voffB);
            PG8_WAIT_V(6); PG8_BAR; PG8_MMA(1, 1, At, B1); PG8_BAR;
            PG8_LDB(B0, 1, 0); PG8_SCHED; PG8_LDA(At, 1, 0); PG8_STAGE(PG8_SA(0, 1), a2 + hstep, voffA);
            PG8_WAIT_L(8); PG8_BAR; PG8_WAIT_L(0); PG8_MMA(0, 0, At, B0); PG8_BAR; PG8_SCHED;
            PG8_LDB(B1, 1, 1); PG8_STAGE(PG8_SB(1, 0), b3, voffB);
            PG8_BAR; PG8_WAIT_L(0); PG8_MMA(0, 1, At, B1); PG8_BAR;
            PG8_LDA(At, 1, 1); PG8_STAGE(PG8_SA(1, 0), a3, voffA);
            PG8_BAR; PG8_WAIT_L(0); PG8_MMA(1, 0, At, B0); PG8_BAR; PG8_SCHED;
            PG8_STAGE(PG8_SB(1, 1), b3 + hstep, voffB);
            PG8_WAIT_V(6); PG8_BAR; PG8_MMA(1, 1, At, B1); PG8_BAR;
            }
        }
        if constexpr (ALIGN_EPI) { if (wr == 0) PG8_BAR; }
        if constexpr (!Epi::AFTER_DRAIN) { E(acc, cur, wr, wc, fr, fq); S.done(cur); }
        if (!has_next) break;
#pragma unroll
        for (int a = 0; a < 2; ++a)
#pragma unroll
            for (int b = 0; b < 2; ++b)
#pragma unroll
                for (int m = 0; m < 4; ++m)
#pragma unroll
                    for (int n = 0; n < 2; ++n) acc[a][b][m][n] = (f32x4){0.f, 0.f, 0.f, 0.f};
        cur = nxt; cA = nA; cB = nB; ++ui;
        if constexpr (ALIGN_EPI) { if (wr == 1) PG8_BAR; }
    }
    PG8_WAIT_V(0);
    if constexpr (!ALIGN_EPI) { if (wr == 0) PG8_BAR; }
    PG8_BAR;
    if constexpr (Epi::AFTER_DRAIN) { E.fused(acc, cur, wr, wc, fr, fq, lds, wid, lane); S.done(cur); }
#undef PG8_SA
#undef PG8_SB
#undef PG8_STAGE
#undef PG8_LDA
#undef PG8_LDB
#undef PG8_MMA
#undef PG8_WAIT_V
#undef PG8_WAIT_L
#undef PG8_BAR
#undef PG8_SCHED
}
}
#include <hip/hip_cooperative_groups.h>
namespace cg = cooperative_groups;
#define LAS __attribute__((address_space(3)))
typedef float f32x4 __attribute__((ext_vector_type(4)));
typedef unsigned u32x2 __attribute__((ext_vector_type(2)));
typedef unsigned u32x4 __attribute__((ext_vector_type(4)));
typedef short bf16x8 __attribute__((ext_vector_type(8)));
constexpr int NTHR = 512, NWAVES = 8, LDS_BYTES = 147456;
#define LDS_WAIT() asm volatile("s_waitcnt lgkmcnt(0)" ::: "memory")
__device__ __forceinline__ unsigned pk2(float lo, float hi) { return pg8::cvt_pk_bf16(lo, hi); }
__device__ __forceinline__ float wave_sum(float v) {
#pragma unroll
    for (int o = 1; o < 64; o <<= 1) v += __shfl_xor(v, o);
    return v;
}
struct Ctx { LAS unsigned char* lds; int tid, lane, wave, gw, ngw; };
__device__ __forceinline__ Ctx mkctx(LAS unsigned char* lds) { Ctx c; c.lds = lds; int t = threadIdx.x; asm volatile("" : "+v"(t)); c.tid = t; c.lane = t & 63; c.wave = __builtin_amdgcn_readfirstlane(t >> 6);
    c.gw = (int)blockIdx.x * NWAVES + c.wave; c.ngw = (int)gridDim.x * NWAVES; return c; }
__device__ __forceinline__ PREF kparams() { const CONSTAS P* q = (const CONSTAS P*)__builtin_amdgcn_kernarg_segment_ptr(); asm volatile("" : "+s"(q)); return *q; }
constexpr int MISC_OFF = 131072;
#define XB_TMO      128
#define XB_XCNT(j)  (256  + 64 * (j))
#define XB_XSUB(j)  (1280 + 64 * (j))
#define XB_XGEN(j)  (2304 + 64 * (j))
#define XB_TOP      3328
#define XB_TOPGEN   3392
#define XCD_BAR_WORDS 3456
#define XB_SPIN_CAP (1u << 18)

__device__ __forceinline__ unsigned xb_ld(unsigned* p)              { return __hip_atomic_load(p, __ATOMIC_RELAXED, __HIP_MEMORY_SCOPE_AGENT); }
__device__ __forceinline__ unsigned xb_add(unsigned* p, unsigned v) { return __hip_atomic_fetch_add(p, v, __ATOMIC_RELAXED, __HIP_MEMORY_SCOPE_AGENT); }
__device__ __forceinline__ unsigned xb_xcc_id() { return (unsigned)__builtin_amdgcn_s_getreg((3 << 11) | 20) & 0xFu; }
#define XB_SPIN(cond, bar) do { unsigned _sp = 0; while (cond) { __builtin_amdgcn_s_sleep(1); \
    if ((++_sp & 255u) == 0u) { if (xb_ld(&(bar)[XB_TMO])) break; if (_sp > XB_SPIN_CAP) { atomicAdd(&(bar)[XB_TMO], 1u); break; } } } } while (0)

struct XcdBarrier {
    unsigned* bar; unsigned x;
    volatile LAS unsigned* st;
};

__device__ __forceinline__ XcdBarrier xcd_barrier_post(unsigned* bar, volatile LAS unsigned* st) {
    XcdBarrier b; b.bar = bar; b.x = xb_xcc_id(); b.st = st;
    if (threadIdx.x == 0) (void)xb_add(&bar[XB_XCNT(b.x)], 1u);
    return b;
}
__device__ __forceinline__ void xcd_barrier_complete(unsigned* bar, unsigned x, unsigned& nloc, unsigned& nx) {
    const unsigned G = gridDim.x * gridDim.y * gridDim.z;
    unsigned sum, cnt, mine, sp = 0u;
    for (;;) {
        sum = 0u; cnt = 0u; mine = 0u;
#pragma unroll
        for (unsigned j = 0; j < 16; ++j) { const unsigned c = xb_ld(&bar[XB_XCNT(j)]); sum += c; cnt += (c > 0u) ? 1u : 0u; mine = (j == x) ? c : mine; }
        if (sum == G) break;
        __builtin_amdgcn_s_sleep(1);
        if ((++sp & 255u) == 0u) { if (xb_ld(&bar[XB_TMO])) break; if (sp > XB_SPIN_CAP) { atomicAdd(&bar[XB_TMO], 1u); break; } }
    }
    nloc = mine > 0u ? mine : 1u; nx = cnt > 0u ? cnt : 1u;
}

__device__ __forceinline__ void xcd_barrier(const XcdBarrier& b) {
    asm volatile("s_waitcnt vmcnt(0)" ::: "memory");
    __syncthreads();
    if (threadIdx.x == 0) {
        unsigned* bar = b.bar;
        __builtin_amdgcn_s_waitcnt(0);
        unsigned nloc = b.st[0], nx = b.st[1];
        if (nloc == 0u) { xcd_barrier_complete(bar, b.x, nloc, nx); b.st[0] = nloc; b.st[1] = nx; }
        const unsigned old = xb_add(&bar[XB_XSUB(b.x)], 1u);
        const unsigned gen = old / nloc;
        if (old + 1u == (gen + 1u) * nloc) {
            __builtin_amdgcn_fence(__ATOMIC_RELEASE, "agent");
            asm volatile("s_waitcnt vmcnt(0)" ::: "memory");
            const unsigned og = xb_add(&bar[XB_TOP], 1u);
            const unsigned tg = og / nx;
            if (og + 1u == (tg + 1u) * nx) xb_add(&bar[XB_TOPGEN], 1u);
            else XB_SPIN(xb_ld(&bar[XB_TOPGEN]) == tg, bar);
            __builtin_amdgcn_fence(__ATOMIC_ACQUIRE, "agent");
            xb_add(&bar[XB_XGEN(b.x)], 1u);
            asm volatile("s_waitcnt vmcnt(0)" ::: "memory");
        } else {
            XB_SPIN(xb_ld(&bar[XB_XGEN(b.x)]) == gen, bar);
            __builtin_amdgcn_fence(__ATOMIC_ACQUIRE, "agent");
            asm volatile("s_waitcnt vmcnt(0)" ::: "memory");
        }
    }
    __syncthreads();
}
__device__ __forceinline__ void grid_barrier(LAS unsigned char* lds) {
    XcdBarrier b; b.bar = (unsigned*)(kparams().ws + WS_CTL); b.x = xb_xcc_id(); b.st = (volatile LAS unsigned*)(lds + MISC_OFF) + 8;
    xcd_barrier(b);
}
#define GRID_SYNC() grid_barrier(lds)

template <class F> __device__ __forceinline__ void run_simple(F f, long n) {
    int tid = threadIdx.x; asm volatile("" : "+v"(tid));
    for (long g = (long)blockIdx.x * NTHR + tid; g < n; g += (long)gridDim.x * NTHR) f(g);
}

__device__ __forceinline__ void transpose_item(const float* W, int N, bf16* WT, int Kd, int k0, int n0, int drow0, LAS float* scr, int lane) {
#pragma unroll 8
    for (int i = 0; i < 32; ++i) { const int kk = 2 * i + (lane >> 5); scr[kk * 33 + (lane & 31)] = W[(size_t)(k0 + kk) * N + n0 + (lane & 31)]; }
    LDS_WAIT();
    const int c = lane & 7;
#pragma unroll
    for (int j = 0; j < 4; ++j) { const int n = (lane >> 3) + 8 * j; const LAS float* s = scr + (8 * c) * 33 + n;
        u32x4 o; o.x = pk2(s[0 * 33], s[1 * 33]); o.y = pk2(s[2 * 33], s[3 * 33]); o.z = pk2(s[4 * 33], s[5 * 33]); o.w = pk2(s[6 * 33], s[7 * 33]);
        *(u32x4*)(WT + (size_t)(drow0 + n) * Kd + k0 + 8 * c) = o; }
    LDS_WAIT();
}
__device__ __forceinline__ void phase_prep(const Ctx& c) {
    PREF p = kparams();
    LAS float* scr = (LAS float*)(c.lds + c.wave * 16384);
    constexpr int I_IN = (DM / 64) * (NIN / 32), I_OUT = (DM / 64) * (DM / 32), I_F = (DM / 64) * (DFF / 32), I_2 = (DFF / 64) * (DM / 32), I_L = I_IN + I_OUT + 2 * I_F + I_2;
    for (int it = c.gw; it < DEPTH * I_L; it += c.ngw) {
        const int l = it / I_L; int r = it % I_L;
        if (r < I_IN) { const float* W = (l % 2 == 0 ? p.w_in_even : p.w_in_odd) + (size_t)(l / 2) * DM * NIN; const int nb = NIN / 32;
            transpose_item(W, NIN, p.Wt_in + (size_t)l * NIN * DM, DM, 64 * (r / nb), 32 * (r % nb), 32 * (r % nb), scr, c.lane); continue; } r -= I_IN;
        if (r < I_OUT) { const float* W = (l % 2 == 0 ? p.w_out_even : p.w_out_odd) + (size_t)(l / 2) * DM * DM; const int nb = DM / 32;
            transpose_item(W, DM, p.Wt_out + (size_t)l * DM * DM, DM, 64 * (r / nb), 32 * (r % nb), 32 * (r % nb), scr, c.lane); continue; } r -= I_OUT;
        if (r < 2 * I_F) { const int half = r >= I_F; if (half) r -= I_F; const float* W = (half ? p.ffn_w3 : p.ffn_w1) + (size_t)l * DM * DFF; const int nb = DFF / 32, n0 = 32 * (r % nb);
            transpose_item(W, DFF, p.Wt_13 + (size_t)l * 2 * DFF * DM, DM, 64 * (r / nb), n0, (n0 >> 7) * 256 + half * 128 + (n0 & 127), scr, c.lane); continue; } r -= 2 * I_F;
        { const float* W = p.ffn_w2 + (size_t)l * DFF * DM; const int nb = DM / 32;
            transpose_item(W, DM, p.Wt_2 + (size_t)l * DM * DFF, DFF, 64 * (r / nb), 32 * (r % nb), 32 * (r % nb), scr, c.lane); }
    }
    for (long i = (long)blockIdx.x * NTHR + c.tid; i < (long)M * DM / 4; i += (long)gridDim.x * NTHR) {
        const f32x4 v = i < (long)MP * DM / 4 ? ((const f32x4*)p.x_prompt)[i] : ((const f32x4*)p.x_sample)[i - (long)MP * DM / 4];
        u32x2 w; w.x = pk2(v.x, v.y); w.y = pk2(v.z, v.w); ((u32x2*)p.XB)[i] = w; }
    run_simple(FRope{p.rope}, (long)(SEQ + 4) * 32);
    for (int i = (int)blockIdx.x * NTHR + c.tid; i < 2 * 8 * 64 * 64; i += (int)gridDim.x * NTHR) { const int eg = i >> 12, j = (i >> 6) & 63, ii = i & 63;
        p.WaT[i] = f2bf(p.lru_wa[eg * 4096 + ii * 64 + j]); p.WxT[i] = f2bf(p.lru_wx[eg * 4096 + ii * 64 + j]); }
    for (int i = (int)blockIdx.x * NTHR + c.tid; i < 2 * 4 * 128 * 128; i += (int)gridDim.x * NTHR) { const int t = (i >> 7) & 127, s2 = i & 127; p.Wtril[i] = s2 <= t ? f2bf(p.sp_w[i]) : (bf16)0; }
}

constexpr int LN_R = 4;
template <bool PROBE = false> __device__ __forceinline__ void phase_ln(const Ctx& c, const float* g, const float* b) {
    PREF p = kparams();
    f32x4 gv[4], bv[4];
#pragma unroll
    for (int j = 0; j < 4; ++j) { gv[j] = ((const f32x4*)g)[c.lane + 64 * j]; bv[j] = ((const f32x4*)b)[c.lane + 64 * j]; }
    for (int row0 = c.gw * LN_R; row0 < M; row0 += c.ngw * LN_R) {
        f32x4 v[LN_R][4]; float s[LN_R], s2[LN_R];
#pragma unroll
        for (int r = 0; r < LN_R; ++r) { const int row = row0 + r < M ? row0 + r : M - 1; const f32x4* xr = (const f32x4*)(p.XF + (size_t)row * DM) + c.lane;
#pragma unroll
            for (int j = 0; j < 4; ++j) v[r][j] = xr[64 * j]; }
#pragma unroll
        for (int r = 0; r < LN_R; ++r) { s[r] = 0.f;
#pragma unroll
            for (int j = 0; j < 4; ++j) s[r] += (v[r][j].x + v[r][j].y) + (v[r][j].z + v[r][j].w); }
#pragma unroll
        for (int o = 1; o < 64; o <<= 1) {
#pragma unroll
            for (int r = 0; r < LN_R; ++r) s[r] += __shfl_xor(s[r], o); }
#pragma unroll
        for (int r = 0; r < LN_R; ++r) { const float mean = s[r] * (1.f / DM); s2[r] = 0.f;
#pragma unroll
            for (int j = 0; j < 4; ++j) { v[r][j] = v[r][j] - mean; s2[r] += (v[r][j].x * v[r][j].x + v[r][j].y * v[r][j].y) + (v[r][j].z * v[r][j].z + v[r][j].w * v[r][j].w); } }
#pragma unroll
        for (int o = 1; o < 64; o <<= 1) {
#pragma unroll
            for (int r = 0; r < LN_R; ++r) s2[r] += __shfl_xor(s2[r], o); }
#pragma unroll
        for (int r = 0; r < LN_R; ++r) if (row0 + r < M) { const float rstd = 1.f / sqrtf(s2[r] * (1.f / DM) + LN_EPS);
            f32x4* xr = (f32x4*)(p.XF + (size_t)(row0 + r) * DM) + c.lane; u32x2* o8 = (u32x2*)(p.XB + (size_t)(row0 + r) * DM) + c.lane;
#pragma unroll
            for (int j = 0; j < 4; ++j) { const f32x4 o = v[r][j] * rstd * gv[j] + bv[j]; xr[64 * j] = PROBE ? v[r][j] + s[r] * (1.f / DM) : o; u32x2 w; w.x = pk2(o.x, o.y); w.y = pk2(o.z, o.w); o8[64 * j] = w; } }
    }
}

template <class Epi> __device__ __forceinline__ void phase_gemm(const Ctx& c, const bf16* A, const bf16* Bt, int Mrows, int N, int K, Epi E) {
    pg8::Gemm g{A, Bt, Mrows, N, K}; pg8::StaticOrder S; S.init(Mrows, N, (int)gridDim.x, (int)blockIdx.x);
    pg8::gemm_phase<Epi, pg8::StaticOrder, true, true>(c.lds, g, S, E);
}

__device__ __forceinline__ void sample_gemm_tail(const Ctx& c, const bf16* A, const bf16* Bt, int K, const float* X, float alpha, float* Xo) {
    constexpr int NU = (MS / 32) * (DM / 64);
    int tid_ = c.tid; asm volatile("" : "+v"(tid_));
    const int lane = tid_ & 63, q = lane >> 4, r16 = lane & 15, w = c.wave;
    for (int u = (int)blockIdx.x; u < NU; u += (int)gridDim.x) {
        const int um = u / (DM / 64), un = u % (DM / 64), kw = K / 8, nks = kw / 32, ng = (nks + 2) / 3;
        const bf16* ap = A + (size_t)(MP + 32 * um + r16) * K + w * kw + 8 * q; const bf16* bp = Bt + (size_t)(64 * un + r16) * K + w * kw + 8 * q;
        f32x4 acc[2][4];
#pragma unroll
        for (int i = 0; i < 2; ++i)
#pragma unroll
            for (int j = 0; j < 4; ++j) acc[i][j] = (f32x4){0.f, 0.f, 0.f, 0.f};
        bf16x8 fa0[3][2], fb0[3][4], fa1[3][2], fb1[3][4];
#define SG_LOAD(fa, fb, g) do { _Pragma("unroll") for (int s = 0; s < 3; ++s) if ((g) * 3 + s < nks) { \
            _Pragma("unroll") for (int i = 0; i < 2; ++i) fa[s][i] = *(const bf16x8*)(ap + (size_t)(16 * i) * K + ((g) * 3 + s) * 32); \
            _Pragma("unroll") for (int j = 0; j < 4; ++j) fb[s][j] = *(const bf16x8*)(bp + (size_t)(16 * j) * K + ((g) * 3 + s) * 32); } } while (0)
#define SG_MMA(fa, fb, g) do { _Pragma("unroll") for (int s = 0; s < 3; ++s) if ((g) * 3 + s < nks) { \
            _Pragma("unroll") for (int i = 0; i < 2; ++i) _Pragma("unroll") for (int j = 0; j < 4; ++j) acc[i][j] = __builtin_amdgcn_mfma_f32_16x16x32_bf16(fb[s][j], fa[s][i], acc[i][j], 0, 0, 0); } } while (0)
        SG_LOAD(fa0, fb0, 0);
        for (int g = 0; g < ng; g += 2) {
            if (g + 1 < ng) SG_LOAD(fa1, fb1, g + 1);
            SG_MMA(fa0, fb0, g);
            if (g + 2 < ng) SG_LOAD(fa0, fb0, g + 2);
            if (g + 1 < ng) SG_MMA(fa1, fb1, g + 1);
        }
#undef SG_LOAD
#undef SG_MMA
        LAS float* Pw = (LAS float*)c.lds + w * 2048;
#pragma unroll
        for (int i = 0; i < 2; ++i)
#pragma unroll
            for (int j = 0; j < 4; ++j) *(LAS f32x4*)(Pw + (16 * i + r16) * 64 + 16 * j + 4 * q) = acc[i][j];
        __syncthreads();
        { const int m = tid_ >> 4, n4 = (tid_ & 15) * 4; f32x4 s0 = {0.f, 0.f, 0.f, 0.f};
#pragma unroll
          for (int ww = 0; ww < 8; ++ww) s0 += *(const LAS f32x4*)((LAS float*)c.lds + ww * 2048 + m * 64 + n4);
          const size_t xo = (size_t)(MP + 32 * um + m) * DM + 64 * un + n4; *(f32x4*)(Xo + xo) = *(const f32x4*)(X + xo) * alpha + s0; }
        __syncthreads();
    }
}

#define FAST_EVEN 1
#define FAST_ODD 1
constexpr int LCH = 64, NCH = SEQ / LCH;
constexpr int N_PBU = (BATCH * NCH / 8) * 8, N_SBU = (MS / 16 / 8) * 8;
constexpr int LRU_W_BYTES = 2 * 64 * 72 * 2, LRU_LDS_WAVE = 11264;
__device__ __forceinline__ float rcp_fast(float x) { return __builtin_amdgcn_rcpf(x); }
__device__ __forceinline__ float gelu_fast(float x) { const float t = x * x; return x * rcp_fast(1.0f + __builtin_amdgcn_exp2f(x * (-2.302208198f - 0.1029432397f * t))); }
__device__ __forceinline__ float silu_fast(float x) { return x * rcp_fast(1.0f + __builtin_amdgcn_exp2f(-1.4426950409f * x)); }
__device__ __forceinline__ float sigmoid_fast(float x) { return rcp_fast(1.0f + __builtin_amdgcn_exp2f(-1.4426950409f * x)); }
template <int MODE> __device__ __forceinline__ void lru_unit(const Ctx& c, PREF p, int e, int sample, int row0, int b, int ch64, int g, int nsb) {
    int lane_ = c.lane; asm volatile("" : "+v"(lane_));
    const int lane = lane_, ch = g * 64 + lane, q = lane >> 4, r16 = lane & 15;
    const LAS bf16* WA = (const LAS bf16*)c.lds; const LAS bf16* WX = WA + 64 * 72;
    LAS unsigned char* wl = c.lds + LRU_W_BYTES + c.wave * LRU_LDS_WAVE;
    LAS bf16* XT = (LAS bf16*)wl; LAS float* GR = (LAS float*)(wl + 2304); LAS float* GI = (LAS float*)(wl + 2304 + 4352);
    const float cw0 = p.conv_a_w[(e * 4 + 0) * 512 + ch], cw1 = p.conv_a_w[(e * 4 + 1) * 512 + ch], cw2 = p.conv_a_w[(e * 4 + 2) * 512 + ch], cw3 = p.conv_a_w[(e * 4 + 3) * 512 + ch];
    const float cb = p.conv_a_b[e * 512 + ch], ba = p.lru_ba[e * 512 + ch], bx = p.lru_bx[e * 512 + ch], sp8 = -8.0f * log1pf(expf(-p.lru_lam[e * 512 + ch]));
    float wb0 = 0.f, wb1 = 0.f, wb2 = 0.f;
    if (MODE == 1) { wb0 = p.conv_b_w[(e * 3 + 0) * 512 + ch]; wb1 = p.conv_b_w[(e * 3 + 1) * 512 + ch]; wb2 = p.conv_b_w[(e * 3 + 2) * 512 + ch]; }
    float h = 0.f, aprod = 1.f, x1 = 0.f, x2 = 0.f, x3 = 0.f, c1 = 0.f, c2 = 0.f;
    const bf16* pr0 = p.PROJ + (size_t)row0 * NIN + ch;
    if (!sample && ch64 > 0) {
        x1 = bf2f(pr0[-1 * NIN]); x2 = bf2f(pr0[-2 * NIN]); x3 = bf2f(pr0[-3 * NIN]);
        if (MODE == 1) { c1 = bf2f(pr0[-1 * NIN + 1536]) * bf2f(pr0[-1 * NIN + 2048]); c2 = bf2f(pr0[-2 * NIN + 1536]) * bf2f(pr0[-2 * NIN + 2048]);
            const float* ap = p.AP + (size_t)b * NCH * 512 + ch; const float* he = p.HE + (size_t)b * NCH * 512 + ch;
            for (int j0 = 0; j0 < ch64; j0 += 8) { float av[8], hv[8];
#pragma unroll
                for (int i = 0; i < 8; ++i) { const int jj = j0 + i < ch64 ? j0 + i : ch64 - 1; av[i] = ap[jj * 512]; hv[i] = he[jj * 512]; }
#pragma unroll
                for (int i = 0; i < 8; ++i) if (j0 + i < ch64) h = av[i] * h + hv[i]; } }
    }
    for (int sb = 0; sb < nsb; ++sb) {
        const int rb = row0 + 16 * sb; const bf16* pr = p.PROJ + (size_t)rb * NIN + ch;
        float xc[16], ga[16], bg[16], cx[16];
        { float xa[16];
#pragma unroll
          for (int t = 0; t < 16; ++t) xa[t] = bf2f(pr[t * NIN]);
          if (MODE == 1) {
#pragma unroll
              for (int t = 0; t < 16; ++t) { ga[t] = bf2f(pr[t * NIN + 512]); bg[t] = bf2f(pr[t * NIN + 1024]); cx[t] = bf2f(pr[t * NIN + 1536]) * bf2f(pr[t * NIN + 2048]); }
          }
          float stc[4][3];
          if (sample) {
#pragma unroll
              for (int s4 = 0; s4 < 4; ++s4) { const float* st = p.state_lru_conv + (size_t)(((((rb - MP) >> 2) + s4) * 2 + e) * 3) * 512 + ch; stc[s4][0] = st[0]; stc[s4][1] = st[512]; stc[s4][2] = st[1024]; }
          }
#pragma unroll
          for (int t = 0; t < 16; ++t) {
              if (sample && (t & 3) == 0) { x3 = stc[t >> 2][0]; x2 = stc[t >> 2][1]; x1 = stc[t >> 2][2]; }
              xc[t] = cb + cw0 * x3 + cw1 * x2 + cw2 * x1 + cw3 * xa[t]; x3 = x2; x2 = x1; x1 = xa[t];
              XT[t * 72 + lane] = f2bf(xc[t]);
          } }
        LDS_WAIT();
        { const bf16x8 y0 = *(const LAS bf16x8*)(XT + r16 * 72 + 8 * q), y1 = *(const LAS bf16x8*)(XT + r16 * 72 + 32 + 8 * q);
#pragma unroll
          for (int nt = 0; nt < 4; ++nt) { f32x4 ar = {0.f, 0.f, 0.f, 0.f}, ai = {0.f, 0.f, 0.f, 0.f};
              ar = __builtin_amdgcn_mfma_f32_16x16x32_bf16(*(const LAS bf16x8*)(WA + (16 * nt + r16) * 72 + 8 * q), y0, ar, 0, 0, 0);
              ar = __builtin_amdgcn_mfma_f32_16x16x32_bf16(*(const LAS bf16x8*)(WA + (16 * nt + r16) * 72 + 32 + 8 * q), y1, ar, 0, 0, 0);
              ai = __builtin_amdgcn_mfma_f32_16x16x32_bf16(*(const LAS bf16x8*)(WX + (16 * nt + r16) * 72 + 8 * q), y0, ai, 0, 0, 0);
              ai = __builtin_amdgcn_mfma_f32_16x16x32_bf16(*(const LAS bf16x8*)(WX + (16 * nt + r16) * 72 + 32 + 8 * q), y1, ai, 0, 0, 0);
              *(LAS f32x4*)(GR + r16 * 68 + 16 * nt + 4 * q) = ar; *(LAS f32x4*)(GI + r16 * 68 + 16 * nt + 4 * q) = ai; } }
        LDS_WAIT();
        float sth[4], sts[4][2];
        if (MODE == 1 && sample) {
#pragma unroll
            for (int s4 = 0; s4 < 4; ++s4) { const int n = ((rb - MP) >> 2) + s4; sth[s4] = p.state_lru_h[(size_t)(n * 2 + e) * 512 + ch];
                const float* s2 = p.state_sconv + (size_t)((n * 2 + e) * 2) * 512 + ch; sts[s4][0] = s2[0]; sts[s4][1] = s2[512]; }
        }
#pragma unroll
        for (int t = 0; t < 16; ++t) {
            const float rg = sigmoid_fast(GR[t * 68 + lane] + ba), ig = sigmoid_fast(GI[t * 68 + lane] + bx);
            const float la = sp8 * rg, a = __builtin_amdgcn_exp2f(1.4426950409f * la), x2a = 2.0f * la;
            const float m2 = x2a > -0.25f ? -x2a * (1.0f + x2a * (0.5f + x2a * (0.16666667f + x2a * (0.041666668f + x2a * (0.0083333338f + x2a * 0.0013888889f))))) : 1.0f - __builtin_amdgcn_exp2f(1.4426950409f * x2a);
            float mult = __builtin_amdgcn_sqrtf(m2);
            if (!sample && ch64 == 0 && sb == 0 && t == 0) mult = 1.0f;
            if (MODE == 1 && sample && (t & 3) == 0) h = sth[t >> 2];
            h = a * h + mult * (ig * xc[t]); aprod *= a;
            if (MODE == 1) {
                const int n = (rb + t - MP) >> 2;
                bf16* yr = p.Y + (size_t)(rb + t) * DM + ch;
                yr[0] = f2bf(h * gelu_fast(ga[t]));
                if (sample && (t & 3) == 0) { c2 = sts[t >> 2][0]; c1 = sts[t >> 2][1]; }
                yr[512] = f2bf(bg[t] * (wb0 * c2 + wb1 * c1 + wb2 * cx[t])); c2 = c1; c1 = cx[t];
                if (sample) { const int tt = t & 3;
                    if (tt >= 1) p.out[O_CAS + ((size_t)(n * 2 + e) * 3 + (tt - 1)) * 512 + ch] = bf2f(pr[t * NIN]);
                    if (tt >= 2) p.out[O_SCS + ((size_t)(n * 2 + e) * 2 + (tt - 2)) * 512 + ch] = cx[t];
                    if (tt == 3) p.out[O_HS + (size_t)(n * 2 + e) * 512 + ch] = h;
                } else if (ch64 == NCH - 1 && sb == LCH / 16 - 1) {
                    if (t >= 13) p.out[O_CAP + ((size_t)(b * 2 + e) * 3 + (t - 13)) * 512 + ch] = bf2f(pr[t * NIN]);
                    if (t >= 14) p.out[O_SCP + ((size_t)(b * 2 + e) * 2 + (t - 14)) * 512 + ch] = cx[t];
                    if (t == 15) p.out[O_HP + (size_t)(b * 2 + e) * 512 + ch] = h;
                }
            }
        }
        LDS_WAIT();
    }
    if (MODE == 0) { p.AP[((size_t)b * NCH + ch64) * 512 + ch] = aprod; p.HE[((size_t)b * NCH + ch64) * 512 + ch] = h; }
}
__device__ __forceinline__ void lru_stage_w(const Ctx& c, PREF p, int e, int g) {
    __syncthreads();
#pragma unroll
    for (int k = 0; k < 2; ++k) { const int it = c.tid + NTHR * k, mat = it >> 9, row = (it >> 3) & 63, ck = it & 7;
        const bf16* src = (mat ? p.WxT : p.WaT) + (size_t)((e * 8 + g) * 64 + row) * 64 + 8 * ck;
        *(LAS u32x4*)((LAS bf16*)c.lds + mat * 64 * 72 + row * 72 + 8 * ck) = *(const u32x4*)src; }
    __syncthreads();
}
template <int MODE> __device__ __forceinline__ void lru_block_unit(const Ctx& c, PREF p, int e, int u) {
    if (u < N_PBU) { const int g = u & 7, chunk = (u >> 3) * 8 + c.wave, b = chunk / NCH, ch64 = chunk % NCH;
        lru_stage_w(c, p, e, g); lru_unit<MODE>(c, p, e, 0, b * SEQ + ch64 * LCH, b, ch64, g, LCH / 16); }
    else { const int v = u - N_PBU, g = v & 7, chunk = (v >> 3) * 8 + c.wave;
        lru_stage_w(c, p, e, g); lru_unit<1>(c, p, e, 1, MP + chunk * 16, 0, 0, g, 1); }
}
__device__ __forceinline__ void mixer_even(LAS unsigned char* lds, int l) {
    const int e = l / 2;
    { const Ctx c = mkctx(lds); PREF p = kparams();
      for (int u = (int)blockIdx.x; u < N_PBU + N_SBU; u += (int)gridDim.x) lru_block_unit<0>(c, p, e, u); }
    GRID_SYNC();
#ifdef PROBE_S1
    { const Ctx c = mkctx(lds); PREF p = kparams();
      for (int u = (int)blockIdx.x; u < N_PBU; u += (int)gridDim.x) lru_block_unit<0>(c, p, e, u); }
    GRID_SYNC();
#endif
    { const Ctx c = mkctx(lds); PREF p = kparams();
      for (int u = (int)blockIdx.x; u < N_PBU; u += (int)gridDim.x) lru_block_unit<1>(c, p, e, u); }
    GRID_SYNC();
}
constexpr int ST = 136, SQ = 72;
constexpr int N_R1 = BATCH * NC * 4, N_RS = DECB * 4, N_GS = DECB;
__device__ __forceinline__ bf16x8 ldsfrag(const LAS bf16* base, int row, int stride, int k0) { return *(const LAS bf16x8*)(base + row * stride + k0); }
__device__ __forceinline__ float gamma_h(int h) { return 1.0f - exp2f(-5.0f - (float)h); }
__device__ __forceinline__ void lds_transpose128(const LAS bf16* NAT, LAS bf16* DST, int tid) {
    for (int it = tid; it < 8192; it += NTHR) { const int d = (it & 7) | (((it >> 6) & 15) << 3), sp = ((it >> 3) & 7) | (((it >> 10) & 7) << 3);
        const unsigned a = NAT[(2 * sp) * ST + d], b = NAT[(2 * sp + 1) * ST + d]; *(LAS unsigned*)(DST + d * ST + 2 * sp) = a | (b << 16); }
}
__device__ __forceinline__ void stage_nat128(const bf16* src, LAS bf16* NAT, int tid) {
    u32x4 v[4];
#pragma unroll
    for (int k = 0; k < 4; ++k) { const int it = tid + NTHR * k, m = it >> 4, ck = it & 15; v[k] = *(const u32x4*)(src + (size_t)m * NIN + 8 * ck); }
#pragma unroll
    for (int k = 0; k < 4; ++k) { const int it = tid + NTHR * k, m = it >> 4, ck = it & 15; *(LAS u32x4*)(NAT + m * ST + 8 * ck) = v[k]; }
}
__device__ __forceinline__ void r1_unit(const Ctx& c, PREF p, int o, int b, int ck, int j) {
    int tid_ = c.tid; asm volatile("" : "+v"(tid_));
    const int tid = tid_, lane = tid & 63, q = lane >> 4, r16 = lane & 15, w = c.wave, row0 = b * SEQ + ck * 128;
    LAS bf16* NAT = (LAS bf16*)c.lds; LAS bf16* VT = (LAS bf16*)(c.lds + 34816); LAS bf16* KT = (LAS bf16*)(c.lds + 69632);
    stage_nat128(p.PROJ + (size_t)row0 * NIN + 512 + j * 128, NAT, tid);
    { const float lg = lgam(j);
#pragma unroll
      for (int kk = 0; kk < 4; ++kk) { const int it = tid + NTHR * kk, i = it & 31, mp = it >> 5; float av[2], bv[2];
#pragma unroll
          for (int s = 0; s < 2; ++s) { const int m = 2 * mp + s; const float* cs = p.rope + ((size_t)(ck * 128 + m) * 32 + i) * 2; const float cc = cs[0], sn = cs[1];
              const bf16* pr = p.PROJ + (size_t)(row0 + m) * NIN + 256 + j * 64 + i; const float k1 = bf2f(pr[0]), k2 = bf2f(pr[32]), f = 0.125f * expf(-(float)m * lg);
              av[s] = (k1 * cc - k2 * sn) * f; bv[s] = (k1 * sn + k2 * cc) * f; }
          *(LAS unsigned*)(KT + i * ST + 2 * mp) = pk2(av[0], av[1]); *(LAS unsigned*)(KT + (i + 32) * ST + 2 * mp) = pk2(bv[0], bv[1]); } }
    __syncthreads();
    lds_transpose128(NAT, VT, tid);
    __syncthreads();
    { bf16x8 yv[4];
#pragma unroll
      for (int ks = 0; ks < 4; ++ks) yv[ks] = ldsfrag(VT, 16 * w + r16, ST, ks * 32 + 8 * q);
      const float g127 = gpow(j, 127); float* kv = p.KVT + ((size_t)(b * NC + ck) * 4 + j) * 8192 + (16 * w + r16) * 64 + 4 * q;
#pragma unroll
      for (int dt = 0; dt < 4; ++dt) { f32x4 acc = {0.f, 0.f, 0.f, 0.f};
#pragma unroll
          for (int ks = 0; ks < 4; ++ks) acc = __builtin_amdgcn_mfma_f32_16x16x32_bf16(ldsfrag(KT, 16 * dt + r16, ST, ks * 32 + 8 * q), yv[ks], acc, 0, 0, 0);
          *(f32x4*)(kv + 16 * dt) = acc * g127; } }
    __syncthreads();
    LAS bf16* VdT = VT; LAS bf16* WL = KT;
    { const int row = tid >> 2, q4 = tid & 3; const bf16* vr = p.PROJ + (size_t)(row0 + row) * NIN + 2048 + 8 * q4;
      u32x4 raw[16];
#pragma unroll
      for (int k = 0; k < 16; ++k) raw[k] = *(const u32x4*)(vr + 32 * k);
      float s = 0.f, s2 = 0.f, keep[32];
#pragma unroll
      for (int k = 0; k < 16; ++k) { float v[8]; v[0] = gelu_fast(bf2f((bf16)(raw[k].x & 0xffff))); v[1] = gelu_fast(bf2f((bf16)(raw[k].x >> 16))); v[2] = gelu_fast(bf2f((bf16)(raw[k].y & 0xffff))); v[3] = gelu_fast(bf2f((bf16)(raw[k].y >> 16)));
          v[4] = gelu_fast(bf2f((bf16)(raw[k].z & 0xffff))); v[5] = gelu_fast(bf2f((bf16)(raw[k].z >> 16))); v[6] = gelu_fast(bf2f((bf16)(raw[k].w & 0xffff))); v[7] = gelu_fast(bf2f((bf16)(raw[k].w >> 16)));
#pragma unroll
          for (int i = 0; i < 8; ++i) { s += v[i]; s2 += v[i] * v[i]; }
          if ((k >> 2) == j) {
#pragma unroll
              for (int i = 0; i < 8; ++i) keep[(k & 3) * 8 + i] = v[i]; } }
      s += __shfl_xor(s, 1); s += __shfl_xor(s, 2); s2 += __shfl_xor(s2, 1); s2 += __shfl_xor(s2, 2);
      const float mean = s * (1.0f / 512), rstd = __builtin_amdgcn_rsqf(fmaxf(s2 * (1.0f / 512) - mean * mean, 0.f) + LN_EPS);
#pragma unroll
      for (int kk = 0; kk < 4; ++kk) { const int cg = 4 * kk + q4;
          const f32x4 g0 = *(const f32x4*)(p.gm_ln_g + o * 512 + 128 * j + 8 * cg), g1 = *(const f32x4*)(p.gm_ln_g + o * 512 + 128 * j + 8 * cg + 4);
          const f32x4 b0 = *(const f32x4*)(p.gm_ln_b + o * 512 + 128 * j + 8 * cg), b1 = *(const f32x4*)(p.gm_ln_b + o * 512 + 128 * j + 8 * cg + 4);
          const float* v = keep + kk * 8; u32x4 o4;
          o4.x = pk2((v[0] - mean) * rstd * g0.x + b0.x, (v[1] - mean) * rstd * g0.y + b0.y); o4.y = pk2((v[2] - mean) * rstd * g0.z + b0.z, (v[3] - mean) * rstd * g0.w + b0.w);
          o4.z = pk2((v[4] - mean) * rstd * g1.x + b1.x, (v[5] - mean) * rstd * g1.y + b1.y); o4.w = pk2((v[6] - mean) * rstd * g1.z + b1.z, (v[7] - mean) * rstd * g1.w + b1.w);
          *(LAS u32x4*)(NAT + row * ST + 8 * cg) = o4; } }
    { const bf16* wsrc = p.Wtril + (size_t)((o * 4 + j) * 128) * 128;
      u32x4 v[4];
#pragma unroll
      for (int k = 0; k < 4; ++k) { const int it = tid + NTHR * k, t = it >> 4, ck2 = it & 15; v[k] = *(const u32x4*)(wsrc + t * 128 + 8 * ck2); }
#pragma unroll
      for (int k = 0; k < 4; ++k) { const int it = tid + NTHR * k, t = it >> 4, ck2 = it & 15; *(LAS u32x4*)(WL + t * ST + 8 * ck2) = v[k]; } }
    __syncthreads();
    lds_transpose128(NAT, VdT, tid);
    __syncthreads();
    { const int nks = (w >> 1) + 1, t = 16 * w + r16; bf16x8 yw[4];
#pragma unroll
      for (int ks = 0; ks < 4; ++ks) yw[ks] = ldsfrag(WL, t, ST, ks * 32 + 8 * q);
      const float sb = p.sp_b[(o * 4 + j) * 128 + t];
      const bf16* ur = p.PROJ + (size_t)(row0 + t) * NIN + 1536 + j * 128 + 4 * q; bf16* yr = p.Y + (size_t)(row0 + t) * DM + 512 + j * 128 + 4 * q;
#pragma unroll
      for (int dt = 0; dt < 8; ++dt) { f32x4 acc = {0.f, 0.f, 0.f, 0.f};
#pragma unroll
          for (int ks = 0; ks < 4; ++ks) if (ks < nks) acc = __builtin_amdgcn_mfma_f32_16x16x32_bf16(ldsfrag(VdT, 16 * dt + r16, ST, ks * 32 + 8 * q), yw[ks], acc, 0, 0, 0);
          const u32x2 uu = *(const u32x2*)(ur + 16 * dt);
          u32x2 o2; o2.x = pk2(gelu_fast(bf2f((bf16)(uu.x & 0xffff))) * (acc.x + sb), gelu_fast(bf2f((bf16)(uu.x >> 16))) * (acc.y + sb));
          o2.y = pk2(gelu_fast(bf2f((bf16)(uu.y & 0xffff))) * (acc.z + sb), gelu_fast(bf2f((bf16)(uu.y >> 16))) * (acc.w + sb));
          *(u32x2*)(yr + 16 * dt) = o2; } }
    __syncthreads();
}
__device__ __forceinline__ void r2_unit(const Ctx& c, PREF p, int o, int b, int ck, int h) {
    int tid_ = c.tid; asm volatile("" : "+v"(tid_));
    const int tid = tid_, lane = tid & 63, q = lane >> 4, r16 = lane & 15, w = c.wave, row0 = b * SEQ + ck * 128;
    LAS bf16* QL = (LAS bf16*)c.lds; LAS bf16* KL = (LAS bf16*)(c.lds + 18432); LAS bf16* S0T = (LAS bf16*)(c.lds + 36864); LAS bf16* VT = (LAS bf16*)(c.lds + 55296); LAS bf16* PM = (LAS bf16*)(c.lds + 90112);
    LAS bf16* NAT = PM;
    stage_nat128(p.PROJ + (size_t)row0 * NIN + 512 + h * 128, NAT, tid);
    { const float lg = lgam(h);
#pragma unroll
      for (int kk = 0; kk < 8; ++kk) { const int it = tid + NTHR * kk, i = it & 31, m = it >> 5; const float* cs = p.rope + ((size_t)(ck * 128 + m) * 32 + i) * 2; const float cc = cs[0], sn = cs[1];
          const bf16* pr = p.PROJ + (size_t)(row0 + m) * NIN + h * 64 + i; const float q1 = bf2f(pr[0]), q2 = bf2f(pr[32]), k1 = bf2f(pr[256]), k2 = bf2f(pr[288]);
          const float gl = expf((float)m * lg), gk = 0.125f * expf(-(float)m * lg);
          QL[m * SQ + i] = f2bf((q1 * cc - q2 * sn) * gl); QL[m * SQ + i + 32] = f2bf((q1 * sn + q2 * cc) * gl);
          KL[m * SQ + i] = f2bf((k1 * cc - k2 * sn) * gk); KL[m * SQ + i + 32] = f2bf((k1 * sn + k2 * cc) * gk); } }
    { const float g128 = gpow(h, 128);
      float S[16];
#pragma unroll
      for (int k = 0; k < 16; ++k) S[k] = 0.f;
      for (int jc = 0; jc < ck; ++jc) { const float* kv = p.KVT + ((size_t)(b * NC + jc) * 4 + h) * 8192 + tid; float v[16];
#pragma unroll
          for (int k = 0; k < 16; ++k) v[k] = kv[NTHR * k];
#pragma unroll
          for (int k = 0; k < 16; ++k) S[k] = g128 * S[k] + v[k]; }
#pragma unroll
      for (int k = 0; k < 16; ++k) { const int idx = tid + NTHR * k, e = idx >> 6, d = idx & 63; S0T[e * SQ + d] = f2bf(S[k]); }
      if (ck == NC - 1) { const float* kv = p.KVT + ((size_t)(b * NC + ck) * 4 + h) * 8192 + tid;
#pragma unroll
          for (int k = 0; k < 16; ++k) { const int idx = tid + NTHR * k, e = idx >> 6, d = idx & 63; p.out[O_RP + ((size_t)(b * 2 + o) * 4 + h) * 8192 + d * 128 + e] = g128 * S[k] + kv[NTHR * k]; } } }
    __syncthreads();
    lds_transpose128(NAT, VT, tid);
    __syncthreads();
    const int l = 16 * w + r16; bf16x8 yq[2];
#pragma unroll
    for (int ks = 0; ks < 2; ++ks) yq[ks] = ldsfrag(QL, l, SQ, ks * 32 + 8 * q);
#pragma unroll
    for (int mt = 0; mt < 8; ++mt) { f32x4 acc = {0.f, 0.f, 0.f, 0.f};
        if (mt <= w) {
#pragma unroll
            for (int ks = 0; ks < 2; ++ks) acc = __builtin_amdgcn_mfma_f32_16x16x32_bf16(ldsfrag(KL, 16 * mt + r16, SQ, ks * 32 + 8 * q), yq[ks], acc, 0, 0, 0);
            const int mb = 16 * mt + 4 * q;
            acc.x = (mb + 0 <= l) ? acc.x : 0.f; acc.y = (mb + 1 <= l) ? acc.y : 0.f; acc.z = (mb + 2 <= l) ? acc.z : 0.f; acc.w = (mb + 3 <= l) ? acc.w : 0.f; }
        u32x2 o2; o2.x = pk2(acc.x, acc.y); o2.y = pk2(acc.z, acc.w); *(LAS u32x2*)(PM + l * ST + 16 * mt + 4 * q) = o2; }
    LDS_WAIT();
    bf16x8 yp[4];
#pragma unroll
    for (int ks = 0; ks < 4; ++ks) yp[ks] = ldsfrag(PM, l, ST, ks * 32 + 8 * q);
    const int nks = (w >> 1) + 1; const float gam = gamma_h(h);
    f32x4 ov[8]; float s = 0.f;
#pragma unroll
    for (int et = 0; et < 8; ++et) { f32x4 acc = {0.f, 0.f, 0.f, 0.f};
#pragma unroll
        for (int ks = 0; ks < 2; ++ks) acc = __builtin_amdgcn_mfma_f32_16x16x32_bf16(ldsfrag(S0T, 16 * et + r16, SQ, ks * 32 + 8 * q), yq[ks], acc, 0, 0, 0);
        acc = acc * gam;
#pragma unroll
        for (int ks = 0; ks < 4; ++ks) if (ks < nks) acc = __builtin_amdgcn_mfma_f32_16x16x32_bf16(ldsfrag(VT, 16 * et + r16, ST, ks * 32 + 8 * q), yp[ks], acc, 0, 0, 0);
        ov[et] = acc; s += (acc.x + acc.y) + (acc.z + acc.w); }
    s += __shfl_xor(s, 16); s += __shfl_xor(s, 32);
    const float mean = s * (1.0f / 128); float s2 = 0.f;
#pragma unroll
    for (int et = 0; et < 8; ++et) { ov[et] = ov[et] - mean; s2 += (ov[et].x * ov[et].x + ov[et].y * ov[et].y) + (ov[et].z * ov[et].z + ov[et].w * ov[et].w); }
    s2 += __shfl_xor(s2, 16); s2 += __shfl_xor(s2, 32);
    const float rstd = __builtin_amdgcn_rsqf(s2 * (1.0f / 128) + LN_EPS);
    { const bf16* gr = p.PROJ + (size_t)(row0 + l) * NIN + 1024 + h * 128 + 4 * q; bf16* yr = p.Y + (size_t)(row0 + l) * DM + h * 128 + 4 * q; const float* gn = p.ret_gn_g + o * 512 + h * 128 + 4 * q;
#pragma unroll
      for (int et = 0; et < 8; ++et) { const u32x2 gg = *(const u32x2*)(gr + 16 * et); const f32x4 gw = *(const f32x4*)(gn + 16 * et); const f32x4 v = ov[et] * rstd * gw;
          u32x2 o2; o2.x = pk2(silu_fast(bf2f((bf16)(gg.x & 0xffff))) * v.x, silu_fast(bf2f((bf16)(gg.x >> 16))) * v.y);
          o2.y = pk2(silu_fast(bf2f((bf16)(gg.y & 0xffff))) * v.z, silu_fast(bf2f((bf16)(gg.y >> 16))) * v.w);
          *(u32x2*)(yr + 16 * et) = o2; } }
    __syncthreads();
}
__device__ __forceinline__ void rs_unit(const Ctx& c, PREF p, int o, int n, int h) {
    int tid_ = c.tid; asm volatile("" : "+v"(tid_));
    const int tid = tid_, lane = tid & 63, row0 = MP + n * 4;
    LAS float* QS = (LAS float*)c.lds; LAS float* KS = QS + 256; LAS float* VS = QS + 512; LAS float* SC = QS + 1024; LAS float* CR = QS + 1056; LAS float* RED = QS + 1056 + 2048;
    if (tid < 128) { const int l = tid >> 5, i = tid & 31; const float* cs = p.rope + ((size_t)(SEQ + l) * 32 + i) * 2; const float cc = cs[0], sn = cs[1];
        const bf16* pr = p.PROJ + (size_t)(row0 + l) * NIN + h * 64 + i; const float q1 = bf2f(pr[0]), q2 = bf2f(pr[32]), k1 = bf2f(pr[256]), k2 = bf2f(pr[288]);
        QS[l * 64 + i] = q1 * cc - q2 * sn; QS[l * 64 + i + 32] = q1 * sn + q2 * cc; KS[l * 64 + i] = 0.125f * (k1 * cc - k2 * sn); KS[l * 64 + i + 32] = 0.125f * (k1 * sn + k2 * cc); }
    { const int l = tid >> 7, e = tid & 127; VS[l * 128 + e] = bf2f(p.PROJ[(size_t)(row0 + l) * NIN + 512 + h * 128 + e]); }
    __syncthreads();
    if (tid < 16) { const int l = tid >> 2, m = tid & 3; float v = 0.f; if (m <= l) { float dot = 0.f; for (int d = 0; d < 64; ++d) dot += QS[l * 64 + d] * KS[m * 64 + d]; v = dot * gpow(h, l - m); } SC[tid] = v; }
    { const int e = tid & 127, dg = tid >> 7; const size_t base = ((size_t)(n * 2 + o) * 4 + h) * 8192; const float g4 = gpow(h, 4), k0 = gpow(h, 3), k1 = gpow(h, 2), k2 = gpow(h, 1);
      float cr0 = 0.f, cr1 = 0.f, cr2 = 0.f, cr3 = 0.f; const float v0 = VS[e], v1 = VS[128 + e], v2 = VS[256 + e], v3 = VS[384 + e];
      float s0v[16];
#pragma unroll
      for (int dd = 0; dd < 16; ++dd) s0v[dd] = p.state_ret[base + (dg * 16 + dd) * 128 + e];
#pragma unroll
      for (int dd = 0; dd < 16; ++dd) { const int d = dg * 16 + dd; const float s0 = s0v[dd];
          p.out[O_RS + base + d * 128 + e] = g4 * s0 + k0 * KS[d] * v0 + k1 * KS[64 + d] * v1 + k2 * KS[128 + d] * v2 + KS[192 + d] * v3;
          cr0 += QS[d] * s0; cr1 += QS[64 + d] * s0; cr2 += QS[128 + d] * s0; cr3 += QS[192 + d] * s0; }
      CR[(dg * 4 + 0) * 128 + e] = cr0; CR[(dg * 4 + 1) * 128 + e] = cr1; CR[(dg * 4 + 2) * 128 + e] = cr2; CR[(dg * 4 + 3) * 128 + e] = cr3; }
    __syncthreads();
    { const int l = tid >> 7, e = tid & 127; float ovv = (CR[(0 + l) * 128 + e] + CR[(4 + l) * 128 + e] + CR[(8 + l) * 128 + e] + CR[(12 + l) * 128 + e]) * gpow(h, l + 1);
      for (int m = 0; m <= l; ++m) ovv += SC[l * 4 + m] * VS[m * 128 + e];
      const float s = wave_sum(ovv); if (lane == 0) RED[c.wave] = s;
      __syncthreads();
      const float mean = (RED[2 * l] + RED[2 * l + 1]) * (1.0f / 128), d = ovv - mean; const float s2 = wave_sum(d * d); if (lane == 0) RED[8 + c.wave] = s2;
      __syncthreads();
      const float rstd = 1.0f / sqrtf((RED[8 + 2 * l] + RED[8 + 2 * l + 1]) * (1.0f / 128) + LN_EPS);
      const float gt = bf2f(p.PROJ[(size_t)(row0 + l) * NIN + 1024 + h * 128 + e]);
      p.Y[(size_t)(row0 + l) * DM + h * 128 + e] = f2bf(silu_fast(gt) * d * rstd * p.ret_gn_g[o * 512 + h * 128 + e]); }
    __syncthreads();
}
__device__ __forceinline__ void gs_unit(const Ctx& c, PREF p, int o, int n) {
    int tid_ = c.tid; asm volatile("" : "+v"(tid_));
    const int ch = tid_, g = ch >> 7, lane = ch & 63, row0 = MP + n * 4; LAS float* RED = (LAS float*)c.lds;
    float v[4], mean[4], rstd[4];
#pragma unroll
    for (int t = 0; t < 4; ++t) { v[t] = gelu_fast(bf2f(p.PROJ[(size_t)(row0 + t) * NIN + 2048 + ch])); const float s = wave_sum(v[t]); if (lane == 0) RED[t * 8 + c.wave] = s; }
    __syncthreads();
#pragma unroll
    for (int t = 0; t < 4; ++t) { float s = 0.f; for (int k = 0; k < 8; ++k) s += RED[t * 8 + k]; mean[t] = s * (1.0f / 512); v[t] -= mean[t]; }
    __syncthreads();
#pragma unroll
    for (int t = 0; t < 4; ++t) { const float s2 = wave_sum(v[t] * v[t]); if (lane == 0) RED[t * 8 + c.wave] = s2; }
    __syncthreads();
    const float gg = p.gm_ln_g[o * 512 + ch], bb = p.gm_ln_b[o * 512 + ch];
#pragma unroll
    for (int t = 0; t < 4; ++t) { float s = 0.f; for (int k = 0; k < 8; ++k) s += RED[t * 8 + k]; rstd[t] = 1.0f / sqrtf(s * (1.0f / 512) + LN_EPS); v[t] = v[t] * rstd[t] * gg + bb;
        p.out[O_CV + ((size_t)(n * 2 + o) * 4 + t) * 512 + ch] = v[t]; }
#pragma unroll
    for (int t = 0; t < 4; ++t) { float s = p.sp_b[(o * 4 + g) * 128 + t]; const float* wr = p.sp_w + ((size_t)(o * 4 + g) * 128 + t) * 128;
#pragma unroll
        for (int s2 = 0; s2 < 4; ++s2) if (s2 <= t) s += wr[s2] * v[s2];
        p.Y[(size_t)(row0 + t) * DM + 512 + ch] = f2bf(gelu_fast(bf2f(p.PROJ[(size_t)(row0 + t) * NIN + 1536 + ch])) * s); }
    __syncthreads();
}
__device__ __forceinline__ void mixer_odd(LAS unsigned char* lds, int l) {
    const int o = l / 2;
    { const Ctx c = mkctx(lds); PREF p = kparams();
      for (int u = (int)blockIdx.x; u < N_R1 + N_RS + N_GS; u += (int)gridDim.x) {
          if (u < N_R1) r1_unit(c, p, o, u / (NC * 4), (u >> 2) % NC, u & 3);
          else if (u < N_R1 + N_RS) { const int v = u - N_R1; rs_unit(c, p, o, v >> 2, v & 3); }
          else gs_unit(c, p, o, u - N_R1 - N_RS); } }
    GRID_SYNC();
#ifdef PROBE_R1
    { const Ctx c = mkctx(lds); PREF p = kparams();
      for (int u = (int)blockIdx.x; u < N_R1; u += (int)gridDim.x) r1_unit(c, p, o, u / (NC * 4), (u >> 2) % NC, u & 3); }
    GRID_SYNC();
#endif
#ifdef PROBE_RS
    { const Ctx c = mkctx(lds); PREF p = kparams();
      for (int u = N_R1 + (int)blockIdx.x; u < N_R1 + N_RS + N_GS; u += (int)gridDim.x) { if (u < N_R1 + N_RS) { const int v = u - N_R1; rs_unit(c, p, o, v >> 2, v & 3); } else gs_unit(c, p, o, u - N_R1 - N_RS); } }
    GRID_SYNC();
#endif
    { const Ctx c = mkctx(lds); PREF p = kparams();
      for (int u = (int)blockIdx.x; u < N_R1; u += (int)gridDim.x) r2_unit(c, p, o, u / (NC * 4), (u >> 2) % NC, u & 3); }
    GRID_SYNC();
}
__device__ __forceinline__ void mixer_phases(LAS unsigned char* lds, int l) {
#ifdef FAST_EVEN
    if (l % 2 == 0) { mixer_even(lds, l); return; }
#endif
#ifdef FAST_ODD
    if (l % 2 == 1) { mixer_odd(lds, l); return; }
#endif
    for (int grp = 0; grp <= BATCH; ++grp) {
        const int sample = grp == BATCH, r0 = sample ? MP : grp * SEQ, nr = sample ? MS : SEQ, T = sample ? DECS : SEQ, nseq = sample ? DECB : 1;
        if (l % 2 == 0) { const int e = l / 2;
            run_simple(FE1{kparams(), e, r0}, (long)nr * 512); GRID_SYNC(); run_simple(FE2{kparams(), e, r0}, (long)nr * 512); GRID_SYNC();
            run_simple(FE3{kparams(), e, r0, T, sample}, (long)nseq * 512); GRID_SYNC(); run_simple(FE4{kparams(), e, r0}, (long)nr * 512); GRID_SYNC();
        } else { const int o = l / 2;
            run_simple(FO1{kparams(), r0}, (long)nr * 128); GRID_SYNC();
            if (!sample) { run_simple(FO2{kparams(), grp}, (long)NC * 32768); GRID_SYNC(); run_simple(FO3{kparams(), grp, o}, 32768L); GRID_SYNC();
                run_simple(FO4{kparams()}, (long)NC * 65536); GRID_SYNC(); run_simple(FO5{kparams(), grp}, (long)NC * 65536); GRID_SYNC(); }
            else { run_simple(FO5s{kparams(), o}, (long)DECB * 2048); GRID_SYNC(); run_simple(FO3s{kparams(), o}, (long)DECB * 32768); GRID_SYNC(); }
            run_simple(FO6{kparams(), o, r0}, (long)nr * 4); GRID_SYNC(); run_simple(FO7{kparams(), o, r0}, (long)nr); GRID_SYNC(); run_simple(FO8{kparams(), o, r0}, (long)nr * 512); GRID_SYNC();
        }
    }
}

__global__ void __launch_bounds__(NTHR, 2) fwd_megakernel(P p_unused) {
    extern __shared__ __attribute__((aligned(16))) unsigned char lds_raw[];
    LAS unsigned char* lds = (LAS unsigned char*)lds_raw;
    for (int u = threadIdx.x; u < 64; u += NTHR) ((LAS unsigned*)(lds + MISC_OFF))[u] = 0u;
    if (blockIdx.x == 0) for (int u = threadIdx.x; u < XCD_BAR_WORDS; u += NTHR) __hip_atomic_store((unsigned*)(kparams().ws + WS_CTL) + u, 0u, __ATOMIC_RELAXED, __HIP_MEMORY_SCOPE_AGENT);
    __syncthreads();
    { const Ctx c = mkctx(lds); phase_prep(c); }
    cg::this_grid().sync();
    (void)xcd_barrier_post((unsigned*)(kparams().ws + WS_CTL), (volatile LAS unsigned*)(lds + MISC_OFF) + 8);
#ifdef PROBE_PREP
    { const Ctx c = mkctx(lds); phase_prep(c); }
    GRID_SYNC();
#endif
#ifdef PROBE_SYNC
    for (int i = 0; i < PROBE_SYNC; ++i) GRID_SYNC();
#endif
    for (int l = 0; l < DEPTH; ++l) {
        { const Ctx c = mkctx(lds); PREF p = kparams(); phase_gemm(c, p.XB, p.Wt_in + (size_t)l * NIN * DM, M, NIN, DM, pg8::EpiProj{p.PROJ, NIN}); }
        GRID_SYNC();
#ifdef PROBE_G1
        { const Ctx c = mkctx(lds); PREF p = kparams(); phase_gemm(c, p.XB, p.Wt_in + (size_t)l * NIN * DM, M, NIN, DM, pg8::EpiProj{p.PROJ, NIN}); }
        GRID_SYNC();
#endif
        mixer_phases(lds, l);
#ifdef PROBE_EVEN
        if (l % 2 == 0) mixer_phases(lds, l);
#endif
#ifdef PROBE_ODD
        if (l % 2 == 1) mixer_phases(lds, l);
#endif
#ifdef PROBE_G2
        { const Ctx c = mkctx(lds); PREF p = kparams(); phase_gemm(c, p.Y, p.Wt_out + (size_t)l * DM * DM, MP, DM, DM, pg8::EpiRes{(const float*)p.XF, DM, ALPHA, (float*)p.PROJ, -1}); }
        GRID_SYNC();
#endif
#ifdef PROBE_T2
        { const Ctx c = mkctx(lds); PREF p = kparams(); sample_gemm_tail(c, p.Y, p.Wt_out + (size_t)l * DM * DM, DM, p.XF, ALPHA, (float*)p.PROJ - (size_t)MP * DM); }
        GRID_SYNC();
#endif
        { const Ctx c = mkctx(lds); PREF p = kparams();
          const float* rp = l == 0 ? p.x_prompt : p.XF; const float* rs = l == 0 ? p.x_sample - (size_t)MP * DM : p.XF;
          phase_gemm(c, p.Y, p.Wt_out + (size_t)l * DM * DM, MP, DM, DM, pg8::EpiRes{rp, DM, ALPHA, p.XF, -1});
          sample_gemm_tail(c, p.Y, p.Wt_out + (size_t)l * DM * DM, DM, rs, ALPHA, p.XF); }
        GRID_SYNC();
#ifdef PROBE_LN
        { const Ctx c = mkctx(lds); PREF p = kparams(); phase_ln<true>(c, p.ln1_g + l * DM, p.ln1_b + l * DM); }
        GRID_SYNC();
#endif
        { const Ctx c = mkctx(lds); PREF p = kparams(); phase_ln(c, p.ln1_g + l * DM, p.ln1_b + l * DM); }
        GRID_SYNC();
        { const Ctx c = mkctx(lds); PREF p = kparams(); phase_gemm(c, p.XB, p.Wt_13 + (size_t)l * 2 * DFF * DM, M, 2 * DFF, DM, pg8::EpiSwiglu{p.H, DFF}); }
        GRID_SYNC();
#ifdef PROBE_G3
        { const Ctx c = mkctx(lds); PREF p = kparams(); phase_gemm(c, p.XB, p.Wt_13 + (size_t)l * 2 * DFF * DM, M, 2 * DFF, DM, pg8::EpiSwiglu{p.H, DFF}); }
        GRID_SYNC();
#endif
#ifdef PROBE_G4
        { const Ctx c = mkctx(lds); PREF p = kparams(); phase_gemm(c, p.H, p.Wt_2 + (size_t)l * DM * DFF, MP, DM, DFF, pg8::EpiRes{p.XF, DM, ALPHA, p.sA, 4095}); }
        GRID_SYNC();
#endif
#ifdef PROBE_T4
        { const Ctx c = mkctx(lds); PREF p = kparams(); sample_gemm_tail(c, p.H, p.Wt_2 + (size_t)l * DM * DFF, DFF, p.XF, ALPHA, p.sA - (size_t)MP * DM); }
        GRID_SYNC();
#endif
        { const Ctx c = mkctx(lds); PREF p = kparams(); phase_gemm(c, p.H, p.Wt_2 + (size_t)l * DM * DFF, MP, DM, DFF, pg8::EpiRes{p.XF, DM, ALPHA, p.XF, -1});
          sample_gemm_tail(c, p.H, p.Wt_2 + (size_t)l * DM * DFF, DFF, p.XF, ALPHA, p.XF); }
        GRID_SYNC();
        { const Ctx c = mkctx(lds); PREF p = kparams(); phase_ln(c, p.ln2_g + l * DM, p.ln2_b + l * DM); }
        GRID_SYNC();
    }
}
extern "C" void kernel_launch(void* const* d_in, const int* in_sizes, int n_in, void* d_out, int out_size, void* d_ws, size_t ws_size, hipStream_t stream) {
    if (n_in != 30 || (long)out_size != O_END || ws_size < WS_END) { fprintf(stderr, "kernel_launch: unexpected shapes n_in %d out %d (want %ld) ws %zu (want %zu)\n", n_in, out_size, O_END, ws_size, (size_t)WS_END); return; }
    static int grid = 0;
    if (grid == 0) {
        int dev = 0, cus = 0, per_cu = 0;
        (void)hipGetDevice(&dev); (void)hipDeviceGetAttribute(&cus, hipDeviceAttributeMultiprocessorCount, dev);
        (void)hipFuncSetAttribute((const void*)fwd_megakernel, hipFuncAttributeMaxDynamicSharedMemorySize, LDS_BYTES);
        (void)hipOccupancyMaxActiveBlocksPerMultiprocessor(&per_cu, (const void*)fwd_megakernel, NTHR, LDS_BYTES);
        if (per_cu < 1) fprintf(stderr, "kernel_launch: occupancy query says %d blocks/CU\n", per_cu);
        grid = cus;
        (void)hipGetLastError();
    }
    P p{}; setup_P(p, d_in, d_out, d_ws);
    void* args[] = {&p};
    hipError_t e = hipLaunchCooperativeKernel((const void*)fwd_megakernel, dim3(grid), dim3(NTHR), args, LDS_BYTES, stream);
    if (e != hipSuccess) fprintf(stderr, "cooperative launch failed: %s (grid %d)\n", hipGetErrorString(e), grid);
}
```
